# Optimizing an MI355X kernel written in HIP

```python
import jax, jax.numpy as jnp
from jax import lax
import numpy as np

D_MODEL = 1024
BATCH = 4
SEQ = 8192
DEPTH = 4

CHUNK = 64
Q_BLOCK = 128
PLE_DIM = 256
GDN_HEADS = 4
GDN_DK = 128
GDN_DV = 128
CONV_WIDTH = 4
MLA_HEADS = 4
MLA_NOPE = 128
MLA_ROPE = 64
MLA_V = 128
Q_LORA = 384
KV_LORA = 256
ROPE_THETA = 10000.0
D_FF = -(-(8 * D_MODEL) // (3 * 256)) * 256

GDN_QK = GDN_HEADS * GDN_DK
GDN_VW = GDN_HEADS * GDN_DV
MIX_WIDTH = GDN_VW + MLA_HEADS * MLA_V
IN_SIZES = (GDN_QK, GDN_QK, GDN_VW, GDN_VW, GDN_HEADS, GDN_HEADS, Q_LORA, KV_LORA, MLA_ROPE)
IN_SPLITS = tuple(int(v) for v in np.cumsum(IN_SIZES)[:-1])
IN_WIDTH = int(sum(IN_SIZES))
ALPHA = (2.0 * DEPTH) ** 0.25
BETA = (8.0 * DEPTH) ** -0.25
LN_EPS = 1e-5
RMS_EPS = 1e-6

kernel_name = 'hymba_gdn_mla_deepnorm_ple_trunk'


def layer_norm(x, g, b):
    xf = x.astype(jnp.float32)
    mu = jnp.mean(xf, -1, keepdims=True)
    var = jnp.mean(jnp.square(xf - mu), -1, keepdims=True)
    return ((xf - mu) * lax.rsqrt(var + LN_EPS) * g + b).astype(x.dtype)


def rms_norm(x, g):
    xf = x.astype(jnp.float32)
    return (xf * lax.rsqrt(jnp.mean(xf * xf, -1, keepdims=True) + RMS_EPS) * g).astype(x.dtype)


def l2_norm(x):
    xf = x.astype(jnp.float32)
    return xf * lax.rsqrt(jnp.sum(xf * xf, -1, keepdims=True) + RMS_EPS)


def rope_tables(positions):
    inv_freq = ROPE_THETA ** (-jnp.arange(0, MLA_ROPE, 2, dtype=jnp.float32) / MLA_ROPE)
    ang = positions.astype(jnp.float32)[..., None] * inv_freq
    return jnp.cos(ang), jnp.sin(ang)


def apply_rope(x, cos, sin):
    x1, x2 = jnp.split(x.astype(jnp.float32), 2, axis=-1)
    return jnp.concatenate([x1 * cos - x2 * sin, x2 * cos + x1 * sin], -1).astype(x.dtype)


def causal_dwconv(x, w):
    return lax.conv_general_dilated(
        x, w[:, None, :].astype(x.dtype), window_strides=(1,),
        padding=[(CONV_WIDTH - 1, 0)], dimension_numbers=('NWC', 'WIO', 'NWC'),
        feature_group_count=x.shape[-1])


def gated_delta_rule(q, k, v, g, beta):
    B, S, H, DK = q.shape
    DV = v.shape[-1]
    N = S // CHUNK
    f32 = jnp.float32

    def chunks(t):
        t = t.astype(f32).reshape((B, N, CHUNK, H) + t.shape[3:])
        return jnp.moveaxis(t, (1, 3), (0, 2))

    q = chunks(q) * DK ** -0.5
    k = chunks(k)
    v = chunks(v)
    beta = chunks(beta)
    g = jnp.cumsum(chunks(g), axis=-1)
    tri_incl = jnp.tril(jnp.ones((CHUNK, CHUNK), bool))
    tri_strict = jnp.tril(jnp.ones((CHUNK, CHUNK), bool), -1)
    decay = jnp.exp(jnp.where(tri_incl, g[..., :, None] - g[..., None, :], -jnp.inf))
    k_beta = k * beta[..., None]
    lower = jnp.where(tri_strict, jnp.einsum('nbhid,nbhjd->nbhij', k_beta, k) * decay, 0.0)
    rhs = jnp.concatenate([v * beta[..., None], k_beta * jnp.exp(g)[..., None]], -1)
    sol = lax.linalg.triangular_solve(lower + jnp.eye(CHUNK, dtype=f32), rhs,
                                      left_side=True, lower=True, unit_diagonal=True)
    u, w = sol[..., :DV], sol[..., DV:]
    attn = jnp.where(tri_incl, jnp.einsum('nbhid,nbhjd->nbhij', q, k) * decay, 0.0)
    g_last = g[..., -1]
    q_dec = q * jnp.exp(g)[..., None]
    k_dec = k * jnp.exp(g_last[..., None] - g)[..., None]

    def step(state, xs):
        q_c, k_c, u_c, w_c, attn_c, gl = xs
        v_new = u_c - jnp.einsum('bhck,bhkv->bhcv', w_c, state)
        o = jnp.einsum('bhck,bhkv->bhcv', q_c, state) + jnp.einsum('bhij,bhjv->bhiv', attn_c, v_new)
        state = state * jnp.exp(gl)[..., None, None] + jnp.einsum('bhck,bhcv->bhkv', k_c, v_new)
        return state, o

    s0 = jnp.zeros((B, H, DK, DV), f32)
    _, o = lax.scan(step, s0, (q_dec, k_dec, u, w, attn, g_last))
    return jnp.moveaxis(o, (0, 2), (1, 3)).reshape(B, S, H, DV)


def mla_attention(q_nope, q_rope, k_nope, k_rope, v):
    S = q_nope.shape[1]
    scale = (MLA_NOPE + MLA_ROPE) ** -0.5
    frame_chunk = jnp.arange(S) // CHUNK
    outs = []
    for blk in range(S // Q_BLOCK):
        q0, q1 = blk * Q_BLOCK, (blk + 1) * Q_BLOCK
        s = (jnp.einsum('bqhd,bkhd->bhqk', q_nope[:, q0:q1], k_nope[:, :q1])
             + jnp.einsum('bqhd,bkd->bhqk', q_rope[:, q0:q1], k_rope[:, :q1])).astype(jnp.float32) * scale
        mask = frame_chunk[None, :q1] <= frame_chunk[q0:q1, None]
        prob = jax.nn.softmax(jnp.where(mask, s, -jnp.inf), axis=-1).astype(v.dtype)
        outs.append(jnp.einsum('bhqk,bkhd->bqhd', prob, v[:, :q1]))
    return jnp.concatenate(outs, axis=1)


def hybrid_layer(x, p_i, cos, sin, w_in, conv_w, a_log, dt_bias, gdn_norm_g, q_norm_g,
                 w_uq, kv_norm_g, w_ukv, w_out, ln1_g, ln1_b, w_gate_up, w_down,
                 ln2_g, ln2_b, w_ple, w_ple_gate):
    B, S, _ = x.shape
    h = x @ w_in
    q, k, v, z, b, a, c_q, c_kv, k_r = jnp.split(h, IN_SPLITS, axis=-1)

    qkv = jax.nn.silu(causal_dwconv(jnp.concatenate([q, k, v], -1), conv_w))
    q, k, v = jnp.split(qkv, [GDN_QK, 2 * GDN_QK], axis=-1)
    q = l2_norm(q.reshape(B, S, GDN_HEADS, GDN_DK))
    k = l2_norm(k.reshape(B, S, GDN_HEADS, GDN_DK))
    v = v.reshape(B, S, GDN_HEADS, GDN_DV)
    beta = jax.nn.sigmoid(b.astype(jnp.float32))
    g = -jnp.exp(a_log.astype(jnp.float32)) * jax.nn.softplus(a.astype(jnp.float32) + dt_bias)
    o_gdn = gated_delta_rule(q, k, v, g, beta)
    o_gdn = rms_norm(o_gdn, gdn_norm_g) * jax.nn.silu(z.reshape(B, S, GDN_HEADS, GDN_DV).astype(jnp.float32))

    qm = (rms_norm(c_q, q_norm_g) @ w_uq).reshape(B, S, MLA_HEADS, MLA_NOPE + MLA_ROPE)
    q_nope, q_rope = jnp.split(qm, [MLA_NOPE], axis=-1)
    q_rope = apply_rope(q_rope, cos[:, :, None, :], sin[:, :, None, :])
    kv = (rms_norm(c_kv, kv_norm_g) @ w_ukv).reshape(B, S, MLA_HEADS, MLA_NOPE + MLA_V)
    k_nope, v_m = jnp.split(kv, [MLA_NOPE], axis=-1)
    k_rope = apply_rope(k_r, cos, sin)
    o_mla = mla_attention(q_nope, q_rope, k_nope, k_rope, v_m)

    mix = jnp.concatenate([o_gdn.reshape(B, S, GDN_VW).astype(x.dtype),
                           o_mla.reshape(B, S, MLA_HEADS * MLA_V)], axis=-1) @ w_out
    x = layer_norm(ALPHA * x + mix, ln1_g, ln1_b)

    gate, up = jnp.split(x @ w_gate_up, 2, axis=-1)
    x = layer_norm(ALPHA * x + (jax.nn.silu(gate) * up) @ w_down, ln2_g, ln2_b)

    return x + jax.nn.sigmoid(x @ w_ple_gate) * (p_i @ w_ple)


def setup_inputs(seed: int = 0) -> dict:
    key = jax.random.key(seed)
    ks = jax.random.split(key, 24)
    f32 = jnp.float32
    nrm = lambda k, shape, scale: jax.random.normal(k, shape, f32) * scale
    x = jax.random.normal(ks[0], (BATCH, SEQ, D_MODEL), f32)
    p = jax.random.normal(ks[1], (DEPTH, BATCH, SEQ, PLE_DIM), f32)
    offset = jax.random.randint(ks[2], (BATCH, 1), 0, 64) * CHUNK
    positions = (offset + jnp.arange(SEQ, dtype=jnp.int32)[None, :]).astype(jnp.int32)
    dt = jnp.exp(jax.random.uniform(ks[3], (DEPTH, GDN_HEADS), f32) * (np.log(0.1) - np.log(1e-3)) + np.log(1e-3))
    return {
        'x': x,
        'p': p,
        'positions': positions,
        'w_in': nrm(ks[4], (DEPTH, D_MODEL, IN_WIDTH), D_MODEL ** -0.5),
        'conv_w': nrm(ks[5], (DEPTH, CONV_WIDTH, 2 * GDN_QK + GDN_VW), CONV_WIDTH ** -0.5),
        'a_log': jnp.log(jax.random.uniform(ks[6], (DEPTH, GDN_HEADS), f32, 1.0, 16.0)),
        'dt_bias': dt + jnp.log(-jnp.expm1(-dt)),
        'gdn_norm_g': 1.0 + nrm(ks[7], (DEPTH, GDN_DV), 0.1),
        'q_norm_g': 1.0 + nrm(ks[8], (DEPTH, Q_LORA), 0.1),
        'w_uq': nrm(ks[9], (DEPTH, Q_LORA, MLA_HEADS * (MLA_NOPE + MLA_ROPE)), Q_LORA ** -0.5),
        'kv_norm_g': 1.0 + nrm(ks[10], (DEPTH, KV_LORA), 0.1),
        'w_ukv': nrm(ks[11], (DEPTH, KV_LORA, MLA_HEADS * (MLA_NOPE + MLA_V)), KV_LORA ** -0.5),
        'w_out': nrm(ks[12], (DEPTH, MIX_WIDTH, D_MODEL), MIX_WIDTH ** -0.5 * BETA),
        'ln1_g': 1.0 + nrm(ks[13], (DEPTH, D_MODEL), 0.1),
        'ln1_b': nrm(ks[14], (DEPTH, D_MODEL), 0.02),
        'w_gate_up': nrm(ks[15], (DEPTH, D_MODEL, 2 * D_FF), D_MODEL ** -0.5),
        'w_down': nrm(ks[16], (DEPTH, D_FF, D_MODEL), D_FF ** -0.5 * BETA),
        'ln2_g': 1.0 + nrm(ks[17], (DEPTH, D_MODEL), 0.1),
        'ln2_b': nrm(ks[18], (DEPTH, D_MODEL), 0.02),
        'w_ple': nrm(ks[19], (DEPTH, PLE_DIM, D_MODEL), PLE_DIM ** -0.5),
        'w_ple_gate': nrm(ks[20], (DEPTH, D_MODEL, D_MODEL), D_MODEL ** -0.5),
    }


def reference(x, p, positions, w_in, conv_w, a_log, dt_bias, gdn_norm_g, q_norm_g, w_uq,
              kv_norm_g, w_ukv, w_out, ln1_g, ln1_b, w_gate_up, w_down, ln2_g, ln2_b,
              w_ple, w_ple_gate):
    cos, sin = rope_tables(positions)
    for i in range(DEPTH):
        x = hybrid_layer(x, p[i], cos, sin, w_in[i], conv_w[i], a_log[i], dt_bias[i],
                         gdn_norm_g[i], q_norm_g[i], w_uq[i], kv_norm_g[i], w_ukv[i],
                         w_out[i], ln1_g[i], ln1_b[i], w_gate_up[i], w_down[i],
                         ln2_g[i], ln2_b[i], w_ple[i], w_ple_gate[i])
    return x
```

```cpp
#include <hip/hip_runtime.h>
#include <hip/hip_cooperative_groups.h>
#include <cstdio>
#include <cstdint>
namespace cg = cooperative_groups;
#define MEGA 1
namespace pg8 {
#define PG8_LAS __attribute__((address_space(3)))
typedef unsigned short bf16_t;
typedef short bf16x8 __attribute__((ext_vector_type(8)));
typedef float f32x4 __attribute__((ext_vector_type(4)));
typedef unsigned u32x4 __attribute__((ext_vector_type(4)));
constexpr int BM = 256, BK = 64, HALF = 128, HTB = HALF * BK * 2  , STAGE_BYTES = 8 * HTB, NXCD = 8, WGM = 8;

__host__ __device__ __forceinline__ int lds_byte(int r, int c) { const int st = (r >> 4) * 2 + (c >> 5), rr = r & 15, cc = c & 31, ob = rr * 64 + cc * 2; return st * 1024 + (ob ^ (((ob >> 9) & 1) << 5)); }
__host__ __device__ __forceinline__ void stage_rc(int b, int& R, int& C) { const int st = b / 1024, sb = b % 1024, swz = sb ^ (((sb >> 9) & 1) << 5); R = (st >> 1) * 16 + swz / 64; C = (st & 1) * 32 + (swz % 64) / 2; }
__host__ __device__ __forceinline__ int perm32(int rho) { const int n = rho >> 4, i = rho & 15; return 8 * (i >> 2) + 4 * n + (i & 3); }

struct Unit { int pm, pn; };
struct Gemm { const bf16_t* A; const bf16_t* Bt; int M, N, K; };

struct StaticOrder {
    int nM, nN, nwg, G, c;
    __host__ __device__ void init(int M, int N, int G_, int c_) { nM = M / BM; nN = N / BM; nwg = nM * nN; G = G_; c = c_; }
    __host__ __device__ bool next(int i, Unit& u) const {
        const long L = (long)i * G + c; if (L >= nwg) return false;
        int wgid = (int)L; { const int q = nwg / NXCD, r = nwg % NXCD, xcd = wgid % NXCD, off = wgid / NXCD; wgid = (xcd < r ? xcd * (q + 1) : r * (q + 1) + (xcd - r) * q) + off; }
        const int nig = WGM * nN, gid = wgid / nig, fm = gid * WGM, gsz = (nM - fm) < WGM ? (nM - fm) : WGM;
        u.pm = fm + ((wgid % nig) % gsz); u.pn = (wgid % nig) / gsz; return true;
    }
    __device__ __forceinline__ void a_ready(const Unit&) const {}
    __device__ __forceinline__ void done(const Unit&) const {}
};
__device__ __forceinline__ unsigned cvt_pk_bf16(float lo, float hi) { unsigned r; asm volatile("v_cvt_pk_bf16_f32 %0, %1, %2" : "=v"(r) : "v"(lo), "v"(hi)); return r; }

template <class Epi, class Sched, bool ALIGN_EPI = false, bool SP2 = false>
__device__ __forceinline__ void gemm_phase(PG8_LAS unsigned char* lds, const Gemm g, const Sched& S, const Epi& E) {
    int tid_l = threadIdx.x; asm volatile("" : "+v"(tid_l));
    const int tid = tid_l, wid = __builtin_amdgcn_readfirstlane(tid >> 6), lane = tid & 63, wr = wid >> 2, wc = wid & 3, fr = lane & 15, fq = lane >> 4;
    const int K = g.K, nt = K / BK;
    unsigned voffA[2], voffB[2];
#pragma unroll
    for (int i = 0; i < 2; ++i) { int R, C; stage_rc(tid * 16 + i * 8192, R, C); const int Rb = Epi::PERM ? ((R & ~31) + perm32(R & 31)) : R;
        voffA[i] = (unsigned)(R * K + C) * 2u; voffB[i] = (unsigned)(Rb * K + C) * 2u; }
    const size_t kstep = (size_t)(BK * 2);
    const size_t hstep = (size_t)HALF * K * 2;
    const size_t tstep = 2 * hstep;
    const unsigned ldsw = (unsigned)wid * 1024u;
    const int aoff = lds_byte(wr * 64 + fr, fq * 8), boff = lds_byte(wc * 32 + fr, fq * 8);
#define PG8_SA(b, h) (((b) * 2 + (h)) * HTB)
#define PG8_SB(b, h) ((4 + (b) * 2 + (h)) * HTB)
#define PG8_STAGE(bufoff, gbase, voff) do { _Pragma("unroll") for (int _i = 0; _i < 2; ++_i) \
        __builtin_amdgcn_global_load_lds((const unsigned*)((const char*)(gbase) + (voff)[_i]), (PG8_LAS unsigned*)(lds + (bufoff) + ldsw + _i * 8192), 16, 0, 0); } while (0)
#define PG8_LDA(dst, b, h) do { _Pragma("unroll") for (int m = 0; m < 4; ++m) _Pragma("unroll") for (int k = 0; k < 2; ++k) dst[m][k] = *(const PG8_LAS bf16x8*)(lds + PG8_SA(b, h) + aoff + m * 2048 + k * 1024); } while (0)
#define PG8_LDB(dst, b, h) do { _Pragma("unroll") for (int n = 0; n < 2; ++n) _Pragma("unroll") for (int k = 0; k < 2; ++k) dst[n][k] = *(const PG8_LAS bf16x8*)(lds + PG8_SB(b, h) + boff + n * 2048 + k * 1024); } while (0)
#define PG8_MMA(ai, bj, At, Bt) do { __builtin_amdgcn_s_setprio(1); _Pragma("unroll") for (int m = 0; m < 4; ++m) _Pragma("unroll") for (int n = 0; n < 2; ++n) _Pragma("unroll") for (int k = 0; k < 2; ++k) \
        acc[ai][bj][m][n] = __builtin_amdgcn_mfma_f32_16x16x32_bf16(Bt[n][k], At[m][k], acc[ai][bj][m][n], 0, 0, 0); __builtin_amdgcn_s_setprio(0); } while (0)
#define PG8_WAIT_V(n) asm volatile("s_waitcnt vmcnt(" #n ")" ::: "memory")
#define PG8_WAIT_L(n) asm volatile("s_waitcnt lgkmcnt(" #n ")" ::: "memory")
#define PG8_BAR __builtin_amdgcn_s_barrier()
#define PG8_SCHED __builtin_amdgcn_sched_barrier(0)
    Unit cur, nxt; int ui = 0;
    if (!S.next(0, cur)) return;
    f32x4 acc[2][2][4][2];
#pragma unroll
    for (int a = 0; a < 2; ++a)
#pragma unroll
        for (int b = 0; b < 2; ++b)
#pragma unroll
            for (int m = 0; m < 4; ++m)
#pragma unroll
                for (int n = 0; n < 2; ++n) acc[a][b][m][n] = (f32x4){0.f, 0.f, 0.f, 0.f};
    bf16x8 At[4][2], B0[2][2], B1[2][2];
    const char* cA = (const char*)g.A + (size_t)cur.pm * tstep; const char* cB = (const char*)g.Bt + (size_t)cur.pn * tstep;
    S.a_ready(cur);
    if constexpr (SP2) {
        PG8_STAGE(PG8_SB(0, 0), cB, voffB); PG8_STAGE(PG8_SB(0, 1), cB + hstep, voffB); PG8_STAGE(PG8_SA(0, 0), cA, voffA); PG8_STAGE(PG8_SA(0, 1), cA + hstep, voffA);
        if (wr == 1) PG8_BAR;
        PG8_WAIT_V(2); PG8_BAR;
        PG8_STAGE(PG8_SB(1, 0), cB + kstep, voffB); PG8_STAGE(PG8_SA(1, 0), cA + kstep, voffA); PG8_STAGE(PG8_SB(1, 1), cB + hstep + kstep, voffB);
        PG8_WAIT_V(6); PG8_BAR;
    } else {
        PG8_STAGE(PG8_SB(0, 0), cB, voffB); PG8_STAGE(PG8_SA(0, 0), cA, voffA); PG8_STAGE(PG8_SB(0, 1), cB + hstep, voffB); PG8_STAGE(PG8_SA(0, 1), cA + hstep, voffA);
        if (wr == 1) PG8_BAR;
        PG8_WAIT_V(4); PG8_BAR;
        PG8_STAGE(PG8_SB(1, 0), cB + kstep, voffB); PG8_STAGE(PG8_SA(1, 0), cA + kstep, voffA); PG8_STAGE(PG8_SB(1, 1), cB + hstep + kstep, voffB);
        PG8_WAIT_V(6); PG8_BAR;
    }
    for (;;) {
        const bool has_next = S.next(ui + 1, nxt);
        const char* nA = has_next ? (const char*)g.A + (size_t)nxt.pm * tstep : cA; const char* nB = has_next ? (const char*)g.Bt + (size_t)nxt.pn * tstep : cB;
        for (int t = 0; t < nt; t += 2) {
            const bool last = (t == nt - 2);
            const char* a1 = cA + (size_t)(t + 1) * kstep;
            const char* a2 = last ? nA : cA + (size_t)(t + 2) * kstep; const char* b2 = last ? nB : cB + (size_t)(t + 2) * kstep;
            const char* a3 = a2 + kstep; const char* b3 = b2 + kstep;
            if (last && has_next) S.a_ready(nxt);
            if constexpr (SP2) {
            PG8_LDB(B0, 0, 0); PG8_LDB(B1, 0, 1); PG8_SCHED; PG8_LDA(At, 0, 0); PG8_STAGE(PG8_SA(1, 1), a1 + hstep, voffA);
            PG8_WAIT_V(8); PG8_WAIT_L(0); PG8_BAR; PG8_MMA(0, 0, At, B0); PG8_MMA(0, 1, At, B1); PG8_BAR; PG8_SCHED;
            PG8_LDA(At, 0, 1); PG8_STAGE(PG8_SB(0, 0), b2, voffB); PG8_STAGE(PG8_SB(0, 1), b2 + hstep, voffB); PG8_STAGE(PG8_SA(0, 0), a2, voffA);
            PG8_WAIT_V(8); PG8_WAIT_L(0); PG8_BAR; PG8_MMA(1, 0, At, B0); PG8_MMA(1, 1, At, B1); PG8_BAR; PG8_SCHED;
            PG8_LDB(B0, 1, 0); PG8_LDB(B1, 1, 1); PG8_SCHED; PG8_LDA(At, 1, 0); PG8_STAGE(PG8_SA(0, 1), a2 + hstep, voffA);
            PG8_WAIT_V(8); PG8_WAIT_L(0); PG8_BAR; PG8_MMA(0, 0, At, B0); PG8_MMA(0, 1, At, B1); PG8_BAR; PG8_SCHED;
            PG8_LDA(At, 1, 1); PG8_STAGE(PG8_SB(1, 0), b3, voffB); PG8_STAGE(PG8_SB(1, 1), b3 + hstep, voffB); PG8_STAGE(PG8_SA(1, 0), a3, voffA);
            PG8_WAIT_V(8); PG8_WAIT_L(0); PG8_BAR; PG8_MMA(1, 0, At, B0); PG8_MMA(1, 1, At, B1); PG8_BAR; PG8_SCHED;
            } else {
            PG8_LDB(B0, 0, 0); PG8_SCHED; PG8_LDA(At, 0, 0); PG8_STAGE(PG8_SA(1, 1), a1 + hstep, voffA);
            PG8_WAIT_L(8); PG8_BAR; PG8_WAIT_L(0); PG8_MMA(0, 0, At, B0); PG8_BAR; PG8_SCHED;
            PG8_LDB(B1, 0, 1); PG8_STAGE(PG8_SB(0, 0), b2, voffB);
            PG8_BAR; PG8_WAIT_L(0); PG8_MMA(0, 1, At, B1); PG8_BAR;
            PG8_LDA(At, 0, 1); PG8_STAGE(PG8_SA(0, 0), a2, voffA);
            PG8_BAR; PG8_WAIT_L(0); PG8_MMA(1, 0, At, B0); PG8_BAR; PG8_SCHED;
            PG8_STAGE(PG8_SB(0, 1), b2 + hstep, voffB);
            PG8_WAIT_V(6); PG8_BAR; PG8_MMA(1, 1, At, B1); PG8_BAR;
            PG8_LDB(B0, 1, 0); PG8_SCHED; PG8_LDA(At, 1, 0); PG8_STAGE(PG8_SA(0, 1), a2 + hstep, voffA);
            PG8_WAIT_L(8); PG8_BAR; PG8_WAIT_L(0); PG8_MMA(0, 0, At, B0); PG8_BAR; PG8_SCHED;
            PG8_LDB(B1, 1, 1); PG8_STAGE(PG8_SB(1, 0), b3, voffB);
            PG8_BAR; PG8_WAIT_L(0); PG8_MMA(0, 1, At, B1); PG8_BAR;
            PG8_LDA(At, 1, 1); PG8_STAGE(PG8_SA(1, 0), a3, voffA);
            PG8_BAR; PG8_WAIT_L(0); PG8_MMA(1, 0, At, B0); PG8_BAR; PG8_SCHED;
            PG8_STAGE(PG8_SB(1, 1), b3 + hstep, voffB);
            PG8_WAIT_V(6); PG8_BAR; PG8_MMA(1, 1, At, B1); PG8_BAR;
            }
        }
        if constexpr (ALIGN_EPI) { if (wr == 0) PG8_BAR; }
        if constexpr (!Epi::AFTER_DRAIN) { E(acc, cur, wr, wc, fr, fq); S.done(cur); }
        if (!has_next) break;
#pragma unroll
        for (int a = 0; a < 2; ++a)
#pragma unroll
            for (int b = 0; b < 2; ++b)
#pragma unroll
                for (int m = 0; m < 4; ++m)
#pragma unroll
                    for (int n = 0; n < 2; ++n) acc[a][b][m][n] = (f32x4){0.f, 0.f, 0.f, 0.f};
        cur = nxt; cA = nA; cB = nB; ++ui;
        if constexpr (ALIGN_EPI) { if (wr == 1) PG8_BAR; }
    }
    PG8_WAIT_V(0);
    if constexpr (!ALIGN_EPI) { if (wr == 0) PG8_BAR; }
    PG8_BAR;
    if constexpr (Epi::AFTER_DRAIN) { E.fused(acc, cur, wr, wc, fr, fq, lds, wid, lane); S.done(cur); }
#undef PG8_SA
#undef PG8_SB
#undef PG8_STAGE
#undef PG8_LDA
#undef PG8_LDB
#undef PG8_MMA
#undef PG8_WAIT_V
#undef PG8_WAIT_L
#undef PG8_BAR
#undef PG8_SCHED
}
}

#define LAS __attribute__((address_space(3)))
#define DI __device__ __forceinline__
typedef unsigned short bf16_t;
typedef short bf16x8 __attribute__((ext_vector_type(8)));
typedef short s16x4 __attribute__((ext_vector_type(4)));
typedef float f32x2 __attribute__((ext_vector_type(2)));
typedef float f32x4 __attribute__((ext_vector_type(4)));
typedef float f32x16 __attribute__((ext_vector_type(16)));
typedef unsigned u32x4 __attribute__((ext_vector_type(4)));
typedef unsigned u32x2 __attribute__((ext_vector_type(2)));
typedef __bf16 bf16x2_t __attribute__((ext_vector_type(2)));
using pg8::Unit;

constexpr int NB = 4, SEQ = 8192, T = NB * SEQ, DM = 1024, DEPTH = 4, NIN = 2816, NIN_SRC = 2760, DFF = 2816, NT = 512, NWAVE = 8;
constexpr float ALPHA = 1.681792830507429f;
constexpr float LN_EPS = 1e-5f, RMS_EPS = 1e-6f;
constexpr float QSCALE = 0.07216878364870322f * 1.4426950408889634f;
constexpr int LDS_BYTES = 159744, LDS_CTL = 159488;
constexpr int PH_PER_LAYER = 11, NPHASE = DEPTH * PH_PER_LAYER;

constexpr size_t MiB = 1u << 20;
constexpr size_t W_IN = 0, W_UQ = 5767168, W_UKV = 6356992, W_OUT = 6881280, W_GU = 8978432, W_DN = 20512768, W_PG = 26279936, W_PLE = 28377088;
constexpr size_t WS_GW = 28901376;
constexpr int GW_LAYER = 2 * 5632 + 2 * 1024;
constexpr size_t WS_PB = 28 * MiB, WS_COS = 44 * MiB, WS_SIN = 48 * MiB, WS_MISC = 52 * MiB;
constexpr size_t WS_AB = WS_MISC, WS_SSQ = WS_MISC + 1 * MiB, WS_ST1 = WS_SSQ + 256 * 1024, WS_ST2 = WS_ST1 + 256 * 1024, WS_GL = WS_ST2 + 256 * 1024, WS_CTR = WS_GL + 64 * 1024, WS_BAR = WS_CTR + 4096;
constexpr size_t WS_QKV = 54 * MiB, WS_Z = 150 * MiB, WS_CQ = 182 * MiB, WS_CKV = 206 * MiB, WS_KR = 222 * MiB, WS_MIXIN = 54 * MiB, WS_HID = 54 * MiB, WS_E = 54 * MiB;
constexpr size_t WS_WC = 230 * MiB, WS_QD = 262 * MiB, WS_KDT = 294 * MiB, WS_UC = 326 * MiB, WS_AT = 358 * MiB, WS_Y = 230 * MiB;
constexpr size_t WS_QM = 374 * MiB, WS_KN = 422 * MiB, WS_VT = 454 * MiB, WS_X1B = 374 * MiB, WS_XB = 438 * MiB, WS_END = 502 * MiB;

struct Args { const void* in[21]; float* out; unsigned char* ws; int ph_lo, ph_hi; };

DI unsigned pk2(float lo, float hi) { f32x2 v = {lo, hi}; bf16x2_t b = __builtin_convertvector(v, bf16x2_t); return __builtin_bit_cast(unsigned, b); }
DI float lo_bf(unsigned u) { return __uint_as_float(u << 16); }
DI float hi_bf(unsigned u) { return __uint_as_float(u & 0xffff0000u); }
DI float bf2f(bf16_t h) { return __uint_as_float((unsigned)h << 16); }
DI u32x4 pack8(f32x4 a, f32x4 b) { u32x4 w; w.x = pk2(a[0], a[1]); w.y = pk2(a[2], a[3]); w.z = pk2(b[0], b[1]); w.w = pk2(b[2], b[3]); return w; }
DI float wave_sum(float v) {
#pragma unroll
    for (int o = 1; o < 64; o <<= 1) v += __shfl_xor(v, o);
    return v;
}
DI float sigmoidf_(float x) { return __builtin_amdgcn_rcpf(1.f + __expf(-x)); }
DI float siluf_(float x) { return x * __builtin_amdgcn_rcpf(1.f + __expf(-x)); }
#define BLOCK_SYNC() __syncthreads()

struct Ctx {
    const float *x, *p, *w_in, *conv_w, *a_log, *dt_bias, *gdn_g, *qn_g, *w_uq, *kvn_g, *w_ukv, *w_out, *ln1_g, *ln1_b, *w_gu, *w_dn, *ln2_g, *ln2_b, *w_ple, *w_pg;
    const int* pos;
    float* out; unsigned char* ws;
};


__device__ const float INV_FREQ[32] = {1.000000000e+00f, 7.498942018e-01f, 5.623413324e-01f, 4.216965139e-01f, 3.162277639e-01f, 2.371373773e-01f, 1.778279394e-01f, 1.333521456e-01f, 1.000000015e-01f, 7.498942316e-02f, 5.623413250e-02f, 4.216964915e-02f, 3.162277490e-02f, 2.371373773e-02f, 1.778279431e-02f, 1.333521400e-02f, 9.999999776e-03f, 7.498942316e-03f, 5.623413250e-03f, 4.216964822e-03f, 3.162277630e-03f, 2.371373819e-03f, 1.778279431e-03f, 1.333521446e-03f, 1.000000047e-03f, 7.498941850e-04f, 5.623413017e-04f, 4.216965172e-04f, 3.162277571e-04f, 2.371373703e-04f, 1.778279402e-04f, 1.333521504e-04f};
DI void sincos_f32(float a, float& sn, float& cs) {
    const float nf = rintf(a * 0.6366197723675814f);
    float r = fmaf(-nf, 1.570796371e+00f, a); r = fmaf(-nf, -4.371138829e-08f, r); r = fmaf(-nf, -1.776356839e-15f, r);
    const float r2 = r * r;
    const float sp = r + r * r2 * (-1.6666667163e-1f + r2 * (8.3333337680e-3f + r2 * (-1.9841270114e-4f + r2 * 2.7557314297e-6f)));
    const float cp = 1.f + r2 * (-0.5f + r2 * (4.1666667908e-2f + r2 * (-1.3888889225e-3f + r2 * (2.4801587642e-5f + r2 * -2.7557314297e-7f))));
    const int q = (int)nf & 3;
    const float s0 = (q & 1) ? cp : sp, c0 = (q & 1) ? sp : cp;
    sn = (q & 2) ? -s0 : s0; cs = ((q + 1) & 2) ? -c0 : c0;
}
DI int map_col(int kind, int n) {
    if (kind == 0) {
        if (n < 2048) return n;
        if (n < 2432) return 2056 + (n - 2048);
        if (n < 2496) { const int j = n - 2432; return 2696 + (j >> 1) + 32 * (j & 1); }
        if (n < 2504) return 2048 + (n - 2496);
        if (n < 2560) return -1;
        return 2440 + (n - 2560);
    } else if (kind == 1) {
        const int h = n / 192, d = n % 192; if (d < 128) return n; const int j = d - 128; return h * 192 + 128 + (j >> 1) + 32 * (j & 1);
    } else if (kind == 2) {
        const int t = n >> 8, r = n & 255; return r < 128 ? t * 128 + r : 2816 + t * 128 + (r - 128);
    }
    return n;
}
DI void transpose_item(const float* W, int K, int Nsrc, int Ndst, bf16_t* WT, LAS float* scr, int item, int lane, const float* kscale, int kind, const float* lg, const float* lb, float* gw, float* bw) {
    const int nblk = Ndst / 32, kb = item / nblk, nb = item % nblk, k0 = 64 * kb, n0 = 32 * nb;
    const int sc = map_col(kind, n0 + (lane & 31));
    const float* wp = W + (size_t)(k0 + (lane >> 5)) * Nsrc + (sc >= 0 ? sc : 0);
#pragma unroll
    for (int h2 = 0; h2 < 2; ++h2) { float v[16];
#pragma unroll
        for (int i = 0; i < 16; ++i) v[i] = wp[(size_t)(2 * (16 * h2 + i)) * Nsrc];
#pragma unroll
        for (int i = 0; i < 16; ++i) { const int kk = 2 * (16 * h2 + i) + (lane >> 5); float x = sc >= 0 ? v[i] : 0.f; if (kscale) x *= kscale[k0 + kk]; scr[kk * 33 + (lane & 31)] = x; } }
    asm volatile("s_waitcnt lgkmcnt(0)" ::: "memory");
    if (lg) {
        const int nl = lane & 31, hf = lane >> 5; float sg = 0.f, sb = 0.f;
#pragma unroll 8
        for (int kk = 0; kk < 32; ++kk) { const int kq = 32 * hf + kk; const float wv = lo_bf(pk2(scr[kq * 33 + nl], 0.f)); sg += lg[k0 + kq] * wv; sb += lb[k0 + kq] * wv; }
        sg += __shfl_xor(sg, 32); sb += __shfl_xor(sb, 32);
        if (hf == 0) { unsafeAtomicAdd(gw + n0 + nl, sg); unsafeAtomicAdd(bw + n0 + nl, sb); }
    }
    const int c = lane & 7;
#pragma unroll
    for (int j = 0; j < 4; ++j) { const int n = (lane >> 3) + 8 * j; const LAS float* s = scr + (8 * c) * 33 + n;
        u32x4 o; o.x = pk2(s[0 * 33], s[1 * 33]); o.y = pk2(s[2 * 33], s[3 * 33]); o.z = pk2(s[4 * 33], s[5 * 33]); o.w = pk2(s[6 * 33], s[7 * 33]);
        *(u32x4*)(WT + (size_t)(n0 + n) * K + k0 + 8 * c) = o; }
    asm volatile("s_waitcnt lgkmcnt(0)" ::: "memory");
}
DI void phase_p0(LAS unsigned char* lds, const Ctx& c, int l) {
    int tid = threadIdx.x; asm volatile("" : "+v"(tid)); const int lane = tid & 63, wave = __builtin_amdgcn_readfirstlane(tid >> 6);
    LAS float* scr = (LAS float*)(lds + wave * 8704);
    const int gw = blockIdx.x * NWAVE + wave, NGW = gridDim.x * NWAVE;
    unsigned char* ws = c.ws;
    constexpr int I_IN = 16 * 88, I_UQ = 6 * 24, I_UKV = 4 * 32, I_OUT = 16 * 32, I_GU = 16 * 176, I_DN = 44 * 32, I_PG = 16 * 32, I_PLE = 4 * 32;
    constexpr int NIT = I_IN + I_UQ + I_UKV + I_OUT + I_GU + I_DN + I_PG + I_PLE;
    for (int it = gw; it < NIT; it += NGW) {
        int r = it; const float* W; int K, Nsrc, Ndst, kind; size_t wt; const float* ksc = nullptr; const float *lg = nullptr, *lb = nullptr; float *gw = nullptr, *bw = nullptr;
        float* gwl = (float*)(ws + WS_GW) + (size_t)l * GW_LAYER;
        if (r < I_IN) { W = c.w_in + (size_t)l * 1024 * NIN_SRC; K = 1024; Nsrc = NIN_SRC; Ndst = NIN; wt = W_IN; kind = 0; }
        else if ((r -= I_IN) < I_UQ) { W = c.w_uq + (size_t)l * 384 * 768; K = 384; Nsrc = 768; Ndst = 768; wt = W_UQ; kind = 1; ksc = c.qn_g + l * 384; }
        else if ((r -= I_UQ) < I_UKV) { W = c.w_ukv + (size_t)l * 256 * 1024; K = 256; Nsrc = 1024; Ndst = 1024; wt = W_UKV; kind = 3; ksc = c.kvn_g + l * 256; }
        else if ((r -= I_UKV) < I_OUT) { W = c.w_out + (size_t)l * 1024 * 1024; K = 1024; Nsrc = 1024; Ndst = 1024; wt = W_OUT; kind = 3; }
        else if ((r -= I_OUT) < I_GU) { W = c.w_gu + (size_t)l * 1024 * 5632; K = 1024; Nsrc = 5632; Ndst = 5632; wt = W_GU; kind = 2; lg = c.ln1_g + l * DM; lb = c.ln1_b + l * DM; gw = gwl; bw = gwl + 5632; }
        else if ((r -= I_GU) < I_DN) { W = c.w_dn + (size_t)l * 2816 * 1024; K = 2816; Nsrc = 1024; Ndst = 1024; wt = W_DN; kind = 3; }
        else if ((r -= I_DN) < I_PG) { W = c.w_pg + (size_t)l * 1024 * 1024; K = 1024; Nsrc = 1024; Ndst = 1024; wt = W_PG; kind = 3; lg = c.ln2_g + l * DM; lb = c.ln2_b + l * DM; gw = gwl + 2 * 5632; bw = gwl + 2 * 5632 + 1024; }
        else { r -= I_PG; W = c.w_ple + (size_t)l * 256 * 1024; K = 256; Nsrc = 1024; Ndst = 1024; wt = W_PLE; kind = 3; }
        transpose_item(W, K, Nsrc, Ndst, (bf16_t*)(ws + wt), scr, r, lane, ksc, kind, lg, lb, gw, bw);
    }
    const size_t gt = (size_t)blockIdx.x * NT + tid, GT = (size_t)gridDim.x * NT;
    {
        const f32x4* src = (const f32x4*)(c.p + (size_t)l * T * 256); u32x4* dst = (u32x4*)(ws + WS_PB);
        for (size_t i = gt; i < (size_t)T * 256 / 8; i += GT) dst[i] = pack8(src[2 * i], src[2 * i + 1]);
    }
    {
        f32x4* z = (f32x4*)(ws + WS_SSQ);
        for (size_t i = gt; i < (size_t)3 * T * 2 / 4; i += GT) z[i] = (f32x4){0.f, 0.f, 0.f, 0.f};
    }
    if (l == 0) {
        const f32x4* src = (const f32x4*)c.x; u32x4* dst = (u32x4*)(ws + WS_XB);
        for (size_t i = gt; i < (size_t)T * DM / 8; i += GT) dst[i] = pack8(src[2 * i], src[2 * i + 1]);
        float* ct = (float*)(ws + WS_COS); float* st = (float*)(ws + WS_SIN);
        for (size_t i = gt; i < (size_t)T * 32; i += GT) {
            const int t = (int)(i >> 5), j = (int)(i & 31);
            const float ang = (float)c.pos[t] * INV_FREQ[j];
            float sn, cs; sincos_f32(ang, sn, cs);
            ct[i] = cs; st[i] = sn;
        }
        if (blockIdx.x == 0 && tid < 64) ((unsigned*)(ws + WS_CTR))[tid] = 0u;
    }
}

typedef const f32x4 (&AccRef)[2][2][4][2];

struct EpiIn {
    static constexpr bool PERM = true, AFTER_DRAIN = false;
    unsigned char* ws;
    DI void operator()(AccRef acc, const Unit& u, int wr, int wc, int fr, int fq) const {
        unsigned char* w_ = ws; asm volatile("" : "+s"(w_));
        bf16_t *QKV = (bf16_t*)(w_ + WS_QKV), *Z = (bf16_t*)(w_ + WS_Z), *CQ = (bf16_t*)(w_ + WS_CQ), *CKV = (bf16_t*)(w_ + WS_CKV), *KR = (bf16_t*)(w_ + WS_KR); float *AB = (float*)(w_ + WS_AB), *SSQ = (float*)(w_ + WS_SSQ); const float *COS = (const float*)(w_ + WS_COS), *SIN = (const float*)(w_ + WS_SIN);
        const int pn = u.pn, row0 = u.pm * 256 + wr * 64 + fr, cl = wc * 32 + 8 * fq;
        if (pn < 8) {
            bf16_t* base; int ld, c0;
            if (pn < 6) { base = QKV; ld = 1536; c0 = pn * 256; } else { base = Z; ld = 512; c0 = (pn - 6) * 256; }
#pragma unroll
            for (int ai = 0; ai < 2; ++ai)
#pragma unroll
                for (int m = 0; m < 4; ++m) { int row_ = row0 + ai * 128 + m * 16; asm volatile("" : "+v"(row_) :: "memory"); bf16_t* rp = base + (size_t)row_ * ld + c0 + cl;
#pragma unroll
                    for (int bj = 0; bj < 2; ++bj) { f32x4 a = acc[ai][bj][m][0], b = acc[ai][bj][m][1];
                        if (pn >= 6) {
#pragma unroll
                            for (int i = 0; i < 4; ++i) { a[i] = siluf_(a[i]); b[i] = siluf_(b[i]); } }
                        *(u32x4*)(rp + bj * 128) = pack8(a, b); } }
        } else if (pn == 8 || pn == 10) {
            bf16_t* base = pn == 8 ? CQ : CKV; const int ld = pn == 8 ? 384 : 256, which = pn == 8 ? 0 : 1;
#pragma unroll
            for (int ai = 0; ai < 2; ++ai)
#pragma unroll
                for (int m = 0; m < 4; ++m) { int row = row0 + ai * 128 + m * 16; asm volatile("" : "+v"(row) :: "memory"); bf16_t* rp = base + (size_t)row * ld + cl; float ss = 0.f;
#pragma unroll
                    for (int bj = 0; bj < 2; ++bj) { const f32x4 a = acc[ai][bj][m][0], b = acc[ai][bj][m][1]; *(u32x4*)(rp + bj * 128) = pack8(a, b);
                        ss += (a[0] * a[0] + a[1] * a[1]) + (a[2] * a[2] + a[3] * a[3]) + (b[0] * b[0] + b[1] * b[1]) + (b[2] * b[2] + b[3] * b[3]); }
                    ss += __shfl_xor(ss, 16); ss += __shfl_xor(ss, 32);
                    if (fq == 0) unsafeAtomicAdd(SSQ + (size_t)row * 2 + which, ss); }
        } else {
#pragma unroll
            for (int ai = 0; ai < 2; ++ai)
#pragma unroll
                for (int m = 0; m < 4; ++m) { int row = row0 + ai * 128 + m * 16; asm volatile("" : "+v"(row) :: "memory");
                    { const f32x4 a = acc[ai][0][m][0], b = acc[ai][0][m][1]; *(u32x4*)(CQ + (size_t)row * 384 + 256 + cl) = pack8(a, b);
                      float ss = (a[0] * a[0] + a[1] * a[1]) + (a[2] * a[2] + a[3] * a[3]) + (b[0] * b[0] + b[1] * b[1]) + (b[2] * b[2] + b[3] * b[3]);
                      ss += __shfl_xor(ss, 16); ss += __shfl_xor(ss, 32);
                      if (fq == 0) unsafeAtomicAdd(SSQ + (size_t)row * 2, ss); }
                    if (wc < 2) {
                        const int i0 = 16 * wc + 4 * fq; const f32x4 cs = *(const f32x4*)(COS + (size_t)row * 32 + i0), sn = *(const f32x4*)(SIN + (size_t)row * 32 + i0);
                        const f32x4 a = acc[ai][1][m][0], b = acc[ai][1][m][1]; f32x4 oa, ob;
                        oa[0] = a[0] * cs[0] - a[1] * sn[0]; oa[1] = a[1] * cs[0] + a[0] * sn[0]; oa[2] = a[2] * cs[1] - a[3] * sn[1]; oa[3] = a[3] * cs[1] + a[2] * sn[1];
                        ob[0] = b[0] * cs[2] - b[1] * sn[2]; ob[1] = b[1] * cs[2] + b[0] * sn[2]; ob[2] = b[2] * cs[3] - b[3] * sn[3]; ob[3] = b[3] * cs[3] + b[2] * sn[3];
                        *(u32x4*)(KR + (size_t)row * 64 + cl) = pack8(oa, ob);
                    } else if (wc == 2 && fq == 0) {
                        *(f32x4*)(AB + (size_t)row * 8) = acc[ai][1][m][0]; *(f32x4*)(AB + (size_t)row * 8 + 4) = acc[ai][1][m][1];
                    }
                    asm volatile("" ::: "memory"); }
        }
    }
};

struct EpiQ {
    static constexpr bool PERM = true, AFTER_DRAIN = false;
    unsigned char* ws;
    DI void operator()(AccRef acc, const Unit& u, int wr, int wc, int fr, int fq) const {
        unsigned char* w_ = ws; asm volatile("" : "+s"(w_));
        bf16_t* QM = (bf16_t*)(w_ + WS_QM); const float *SSQ = (const float*)(w_ + WS_SSQ), *COS = (const float*)(w_ + WS_COS), *SIN = (const float*)(w_ + WS_SIN);
        const int row0 = u.pm * 256 + wr * 64 + fr, cl = wc * 32 + 8 * fq;
#pragma unroll
        for (int ai = 0; ai < 2; ++ai)
#pragma unroll
            for (int m = 0; m < 4; ++m) { int row = row0 + ai * 128 + m * 16; asm volatile("" : "+v"(row) :: "memory"); const int b = row >> 13, s = row & 8191;
                const float rs = __builtin_amdgcn_rsqf(SSQ[(size_t)row * 2] * (1.f / 384.f) + RMS_EPS) * QSCALE;
#pragma unroll
                for (int bj = 0; bj < 2; ++bj) { const int cg_ = u.pn * 256 + bj * 128 + cl, h = cg_ / 192, d = cg_ % 192;
                    f32x4 a = acc[ai][bj][m][0] * rs, bb = acc[ai][bj][m][1] * rs;
                    if (d >= 128) { const int i0 = (d - 128) >> 1; const f32x4 cs = *(const f32x4*)(COS + (size_t)row * 32 + i0), sn = *(const f32x4*)(SIN + (size_t)row * 32 + i0); f32x4 oa, ob;
                        oa[0] = a[0] * cs[0] - a[1] * sn[0]; oa[1] = a[1] * cs[0] + a[0] * sn[0]; oa[2] = a[2] * cs[1] - a[3] * sn[1]; oa[3] = a[3] * cs[1] + a[2] * sn[1];
                        ob[0] = bb[0] * cs[2] - bb[1] * sn[2]; ob[1] = bb[1] * cs[2] + bb[0] * sn[2]; ob[2] = bb[2] * cs[3] - bb[3] * sn[3]; ob[3] = bb[3] * cs[3] + bb[2] * sn[3];
                        a = oa; bb = ob; }
                    *(u32x4*)(QM + ((size_t)(b * 4 + h) * SEQ + s) * 192 + d) = pack8(a, bb); asm volatile("" ::: "memory"); } }
    }
};

struct EpiKV {
    static constexpr bool PERM = true, AFTER_DRAIN = false;
    unsigned char* ws;
    DI void operator()(AccRef acc, const Unit& u, int wr, int wc, int fr, int fq) const {
        unsigned char* w_ = ws; asm volatile("" : "+s"(w_));
        bf16_t *KN = (bf16_t*)(w_ + WS_KN), *VT = (bf16_t*)(w_ + WS_VT); const float* SSQ = (const float*)(w_ + WS_SSQ);
        const int row0 = u.pm * 256 + wr * 64 + fr, cl = wc * 32 + 8 * fq, h = u.pn;
#pragma unroll
        for (int ai = 0; ai < 2; ++ai)
#pragma unroll
            for (int m = 0; m < 4; ++m) { int row = row0 + ai * 128 + m * 16; asm volatile("" : "+v"(row) :: "memory"); const int b = row >> 13, s = row & 8191;
                const float rs = __builtin_amdgcn_rsqf(SSQ[(size_t)row * 2 + 1] * (1.f / 256.f) + RMS_EPS);
                *(u32x4*)(KN + ((size_t)(b * 4 + h) * SEQ + s) * 128 + cl) = pack8(acc[ai][0][m][0] * rs, acc[ai][0][m][1] * rs);
                bf16_t* vp = VT + ((size_t)(b * 4 + h) * 128 + cl) * SEQ + s;
#pragma unroll
                for (int n = 0; n < 2; ++n)
#pragma unroll
                    for (int i = 0; i < 4; ++i) { *vp = (bf16_t)(pk2(acc[ai][1][m][n][i] * rs, 0.f) & 0xffffu); vp += SEQ; asm volatile("" : "+v"(vp)); } }
    }
};

DI f32x2 ln_stats(const float* ST, int row) {
    const f32x2 a = *(const f32x2*)(ST + (size_t)row * 2); const float mean = a.x * (1.f / DM); const float var = fmaxf(a.y * (1.f / DM) - mean * mean, 0.f);
    return (f32x2){mean, __builtin_amdgcn_rsqf(var + LN_EPS)};
}
struct EpiOut {
    static constexpr bool PERM = true, AFTER_DRAIN = false;
    const float* X; unsigned char* ws; const float* G;
    DI void operator()(AccRef acc, const Unit& u, int wr, int wc, int fr, int fq) const {
        unsigned char* w_ = ws; asm volatile("" : "+s"(w_)); float* Y = (float*)(w_ + WS_Y); bf16_t* YG = (bf16_t*)(w_ + WS_X1B); float* ST = (float*)(w_ + WS_ST1);
        const int row0 = u.pm * 256 + wr * 64 + fr, c0 = u.pn * 256 + wc * 32 + 8 * fq;
        f32x4 xb[2][2][2];
        { int r0_ = row0; asm volatile("" : "+v"(r0_) :: "memory"); const size_t o0 = (size_t)r0_ * DM + c0;
#pragma unroll
          for (int bj = 0; bj < 2; ++bj)
#pragma unroll
            for (int n = 0; n < 2; ++n) xb[0][bj][n] = *(const f32x4*)(X + o0 + bj * 128 + 4 * n); }
#pragma unroll
        for (int it = 0; it < 8; ++it) { const int ai = it >> 2, m = it & 3, cur = it & 1;
            if (it + 1 < 8) { int rn_ = row0 + ((it + 1) >> 2) * 128 + ((it + 1) & 3) * 16; asm volatile("" : "+v"(rn_) :: "memory"); const size_t on = (size_t)rn_ * DM + c0;
#pragma unroll
                for (int bj = 0; bj < 2; ++bj)
#pragma unroll
                    for (int n = 0; n < 2; ++n) xb[cur ^ 1][bj][n] = *(const f32x4*)(X + on + bj * 128 + 4 * n); }
            int row_ = row0 + ai * 128 + m * 16; asm volatile("" : "+v"(row_)); const size_t off = (size_t)row_ * DM + c0; float s1 = 0.f, s2 = 0.f;
#pragma unroll
            for (int bj = 0; bj < 2; ++bj) { f32x4 y[2];
#pragma unroll
                for (int n = 0; n < 2; ++n) { y[n] = xb[cur][bj][n] * ALPHA + acc[ai][bj][m][n]; *(f32x4*)(Y + off + bj * 128 + 4 * n) = y[n];
                    s1 += (y[n][0] + y[n][1]) + (y[n][2] + y[n][3]); s2 += (y[n][0] * y[n][0] + y[n][1] * y[n][1]) + (y[n][2] * y[n][2] + y[n][3] * y[n][3]); }
                const f32x4 g0 = *(const f32x4*)(G + c0 + bj * 128), g1 = *(const f32x4*)(G + c0 + bj * 128 + 4);
                *(u32x4*)(YG + off + bj * 128) = pack8(y[0] * g0, y[1] * g1); }
            s1 += __shfl_xor(s1, 16); s1 += __shfl_xor(s1, 32); s2 += __shfl_xor(s2, 16); s2 += __shfl_xor(s2, 32);
            if (fq == 0) { unsafeAtomicAdd(ST + (size_t)row_ * 2, s1); unsafeAtomicAdd(ST + (size_t)row_ * 2 + 1, s2); } }
    }
};

struct EpiSwiGLU {
    static constexpr bool PERM = true, AFTER_DRAIN = false;
    unsigned char* ws; const float* GW;
    DI void operator()(AccRef acc, const Unit& u, int wr, int wc, int fr, int fq) const {
        unsigned char* w_ = ws; asm volatile("" : "+s"(w_)); bf16_t* HID = (bf16_t*)(w_ + WS_HID); const float* ST = (const float*)(w_ + WS_ST1);
        const int row0 = u.pm * 256 + wr * 64 + fr, c0 = u.pn * 128 + wc * 32 + 8 * fq, wrow = u.pn * 256 + wc * 32 + 8 * fq;
        f32x4 gwv[2][2], bwv[2][2];
#pragma unroll
        for (int bj = 0; bj < 2; ++bj)
#pragma unroll
            for (int n = 0; n < 2; ++n) { gwv[bj][n] = *(const f32x4*)(GW + wrow + bj * 128 + 4 * n); bwv[bj][n] = *(const f32x4*)(GW + 5632 + wrow + bj * 128 + 4 * n); }
        f32x2 sta[8];
#pragma unroll
        for (int it = 0; it < 8; ++it) sta[it] = *(const f32x2*)(ST + (size_t)(row0 + (it >> 2) * 128 + (it & 3) * 16) * 2);
#pragma unroll
        for (int ai = 0; ai < 2; ++ai)
#pragma unroll
            for (int m = 0; m < 4; ++m) { int row_ = row0 + ai * 128 + m * 16; asm volatile("" : "+v"(row_) :: "memory");
                const float mean_ = sta[ai * 4 + m].x * (1.f / DM); const f32x2 st = {mean_, __builtin_amdgcn_rsqf(fmaxf(sta[ai * 4 + m].y * (1.f / DM) - mean_ * mean_, 0.f) + LN_EPS)}; f32x4 o[2];
#pragma unroll
                for (int n = 0; n < 2; ++n) { const f32x4 gt = (acc[ai][0][m][n] - gwv[0][n] * st.x) * st.y + bwv[0][n], up = (acc[ai][1][m][n] - gwv[1][n] * st.x) * st.y + bwv[1][n];
#pragma unroll
                    for (int i = 0; i < 4; ++i) o[n][i] = siluf_(gt[i]) * up[i]; }
                *(u32x4*)(HID + (size_t)row_ * DFF + c0) = pack8(o[0], o[1]); }
    }
};

struct EpiDown {
    static constexpr bool PERM = true, AFTER_DRAIN = false;
    unsigned char* ws; const float *G, *Bv, *G2;
    DI void operator()(AccRef acc, const Unit& u, int wr, int wc, int fr, int fq) const {
        unsigned char* w_ = ws; asm volatile("" : "+s"(w_)); float* Y = (float*)(w_ + WS_Y); bf16_t* YG = (bf16_t*)(w_ + WS_X1B); const float* ST = (const float*)(w_ + WS_ST1); float* ST2 = (float*)(w_ + WS_ST2);
        const int row0 = u.pm * 256 + wr * 64 + fr, c0 = u.pn * 256 + wc * 32 + 8 * fq;
        f32x4 yb[2][2][2]; f32x2 sb[2];
        { int r0_ = row0; asm volatile("" : "+v"(r0_) :: "memory"); const size_t o0 = (size_t)r0_ * DM + c0; sb[0] = *(const f32x2*)(ST + (size_t)r0_ * 2);
#pragma unroll
          for (int bj = 0; bj < 2; ++bj)
#pragma unroll
            for (int n = 0; n < 2; ++n) yb[0][bj][n] = *(const f32x4*)(Y + o0 + bj * 128 + 4 * n); }
#pragma unroll
        for (int it = 0; it < 8; ++it) { const int ai = it >> 2, m = it & 3, cur = it & 1;
            if (it + 1 < 8) { int rn_ = row0 + ((it + 1) >> 2) * 128 + ((it + 1) & 3) * 16; asm volatile("" : "+v"(rn_) :: "memory"); const size_t on = (size_t)rn_ * DM + c0; sb[cur ^ 1] = *(const f32x2*)(ST + (size_t)rn_ * 2);
#pragma unroll
                for (int bj = 0; bj < 2; ++bj)
#pragma unroll
                    for (int n = 0; n < 2; ++n) yb[cur ^ 1][bj][n] = *(const f32x4*)(Y + on + bj * 128 + 4 * n); }
            int row = row0 + ai * 128 + m * 16; asm volatile("" : "+v"(row)); const size_t off = (size_t)row * DM + c0; float s1 = 0.f, s2 = 0.f;
            const float mean = sb[cur].x * (1.f / DM); const float rstd = __builtin_amdgcn_rsqf(fmaxf(sb[cur].y * (1.f / DM) - mean * mean, 0.f) + LN_EPS);
#pragma unroll
            for (int bj = 0; bj < 2; ++bj) { f32x4 y[2];
#pragma unroll
                for (int n = 0; n < 2; ++n) { const int cc = c0 + bj * 128 + 4 * n; const f32x4 gv = *(const f32x4*)(G + cc), bv = *(const f32x4*)(Bv + cc);
                    const f32x4 x1 = (yb[cur][bj][n] - mean) * rstd * gv + bv;
                    y[n] = x1 * ALPHA + acc[ai][bj][m][n]; *(f32x4*)(Y + off + bj * 128 + 4 * n) = y[n];
                    s1 += (y[n][0] + y[n][1]) + (y[n][2] + y[n][3]); s2 += (y[n][0] * y[n][0] + y[n][1] * y[n][1]) + (y[n][2] * y[n][2] + y[n][3] * y[n][3]); }
                const f32x4 g0 = *(const f32x4*)(G2 + c0 + bj * 128), g1 = *(const f32x4*)(G2 + c0 + bj * 128 + 4);
                *(u32x4*)(YG + off + bj * 128) = pack8(y[0] * g0, y[1] * g1); }
            s1 += __shfl_xor(s1, 16); s1 += __shfl_xor(s1, 32); s2 += __shfl_xor(s2, 16); s2 += __shfl_xor(s2, 32);
            if (fq == 0) { unsafeAtomicAdd(ST2 + (size_t)row * 2, s1); unsafeAtomicAdd(ST2 + (size_t)row * 2 + 1, s2); } }
    }
};

struct EpiE {
    static constexpr bool PERM = true, AFTER_DRAIN = false;
    unsigned char* ws;
    DI void operator()(AccRef acc, const Unit& u, int wr, int wc, int fr, int fq) const {
        unsigned char* w_ = ws; asm volatile("" : "+s"(w_)); bf16_t* E = (bf16_t*)(w_ + WS_E);
        const int row0 = u.pm * 256 + wr * 64 + fr, c0 = u.pn * 256 + wc * 32 + 8 * fq;
#pragma unroll
        for (int ai = 0; ai < 2; ++ai)
#pragma unroll
            for (int m = 0; m < 4; ++m) { int row_ = row0 + ai * 128 + m * 16; asm volatile("" : "+v"(row_) :: "memory"); const size_t off = (size_t)row_ * DM + c0;
#pragma unroll
                for (int bj = 0; bj < 2; ++bj) *(u32x4*)(E + off + bj * 128) = pack8(acc[ai][bj][m][0], acc[ai][bj][m][1]); }
    }
};

struct EpiPle {
    static constexpr bool PERM = true, AFTER_DRAIN = false;
    unsigned char* ws; const float *G, *Bv; float* OUT; const float* GW;
    DI void operator()(AccRef acc, const Unit& u, int wr, int wc, int fr, int fq) const {
        unsigned char* w_ = ws; asm volatile("" : "+s"(w_)); const float *Y = (const float*)(w_ + WS_Y), *ST = (const float*)(w_ + WS_ST2); const bf16_t* E = (const bf16_t*)(w_ + WS_E); bf16_t* XB = (bf16_t*)(w_ + WS_XB);
        const int row0 = u.pm * 256 + wr * 64 + fr, c0 = u.pn * 256 + wc * 32 + 8 * fq;
        f32x4 yb[2][2][2]; u32x4 eb[2][2]; f32x2 sb[2];
        { int r0_ = row0; asm volatile("" : "+v"(r0_) :: "memory"); const size_t o0 = (size_t)r0_ * DM + c0; sb[0] = *(const f32x2*)(ST + (size_t)r0_ * 2);
#pragma unroll
          for (int bj = 0; bj < 2; ++bj) { eb[0][bj] = *(const u32x4*)(E + o0 + bj * 128);
#pragma unroll
            for (int n = 0; n < 2; ++n) yb[0][bj][n] = *(const f32x4*)(Y + o0 + bj * 128 + 4 * n); } }
#pragma unroll
        for (int it = 0; it < 8; ++it) { const int ai = it >> 2, m = it & 3, cur = it & 1;
            if (it + 1 < 8) { int rn_ = row0 + ((it + 1) >> 2) * 128 + ((it + 1) & 3) * 16; asm volatile("" : "+v"(rn_) :: "memory"); const size_t on = (size_t)rn_ * DM + c0; sb[cur ^ 1] = *(const f32x2*)(ST + (size_t)rn_ * 2);
#pragma unroll
                for (int bj = 0; bj < 2; ++bj) { eb[cur ^ 1][bj] = *(const u32x4*)(E + on + bj * 128);
#pragma unroll
                    for (int n = 0; n < 2; ++n) yb[cur ^ 1][bj][n] = *(const f32x4*)(Y + on + bj * 128 + 4 * n); } }
            int row = row0 + ai * 128 + m * 16; asm volatile("" : "+v"(row)); const size_t off = (size_t)row * DM + c0;
            const float mean = sb[cur].x * (1.f / DM); const float rstd = __builtin_amdgcn_rsqf(fmaxf(sb[cur].y * (1.f / DM) - mean * mean, 0.f) + LN_EPS);
#pragma unroll
            for (int bj = 0; bj < 2; ++bj)
#pragma unroll
                for (int n = 0; n < 2; ++n) { const int cc = c0 + bj * 128 + 4 * n; const f32x4 gv = *(const f32x4*)(G + cc), bv = *(const f32x4*)(Bv + cc), gw = *(const f32x4*)(GW + cc), bw = *(const f32x4*)(GW + 1024 + cc);
                    const unsigned e0 = eb[cur][bj][2 * n], e1 = eb[cur][bj][2 * n + 1]; const f32x4 ev = {lo_bf(e0), hi_bf(e0), lo_bf(e1), hi_bf(e1)};
                    const f32x4 x2 = (yb[cur][bj][n] - mean) * rstd * gv + bv; const f32x4 a = (acc[ai][bj][m][n] - gw * mean) * rstd + bw; f32x4 o;
#pragma unroll
                    for (int i = 0; i < 4; ++i) o[i] = x2[i] + sigmoidf_(a[i]) * ev[i];
                    *(f32x4*)(OUT + off + bj * 128 + 4 * n) = o; u32x2 w2; w2.x = pk2(o[0], o[1]); w2.y = pk2(o[2], o[3]);
                    *(u32x2*)(XB + off + bj * 128 + 4 * n) = w2; } }
    }
};

template <class Epi> DI void run_gemm(LAS unsigned char* lds, const bf16_t* A, const bf16_t* Bt, int M, int N, int K, const Epi& E) {
    asm volatile("" : "+s"(K));
    pg8::Gemm g{A, Bt, M, N, K}; pg8::StaticOrder S; S.init(M, N, (int)gridDim.x, (int)blockIdx.x);
    pg8::gemm_phase<Epi, pg8::StaticOrder, true, true>(lds, g, S, E);
    __syncthreads();
}

DI void phase_ln(const float* Y, const float* G, const float* Bv, bf16_t* XN, float* ST) {
    int tid = threadIdx.x; asm volatile("" : "+v"(tid)); const int lane = tid & 63, wave = __builtin_amdgcn_readfirstlane(tid >> 6);
    const int gw = blockIdx.x * NWAVE + wave, NGW = gridDim.x * NWAVE;
    f32x4 gv[4], bv[4];
#pragma unroll
    for (int j = 0; j < 4; ++j) { gv[j] = *(const f32x4*)(G + 4 * lane + 256 * j); bv[j] = *(const f32x4*)(Bv + 4 * lane + 256 * j); }
    for (int row = gw; row < T; row += NGW) {
        const f32x4* yr = (const f32x4*)(Y + (size_t)row * DM) + lane; f32x4 v[4]; float s = 0.f;
#pragma unroll
        for (int j = 0; j < 4; ++j) { v[j] = yr[64 * j]; s += (v[j][0] + v[j][1]) + (v[j][2] + v[j][3]); }
        const float mean = wave_sum(s) * (1.f / DM); float s2 = 0.f;
#pragma unroll
        for (int j = 0; j < 4; ++j) { v[j] = v[j] - mean; s2 += (v[j][0] * v[j][0] + v[j][1] * v[j][1]) + (v[j][2] * v[j][2] + v[j][3] * v[j][3]); }
        const float rstd = __builtin_amdgcn_rsqf(wave_sum(s2) * (1.f / DM) + LN_EPS);
        u32x2* o8 = (u32x2*)(XN + (size_t)row * DM) + lane;
#pragma unroll
        for (int j = 0; j < 4; ++j) { const f32x4 o = v[j] * rstd * gv[j] + bv[j]; u32x2 w; w.x = pk2(o[0], o[1]); w.y = pk2(o[2], o[3]); o8[64 * j] = w; }
        if (lane == 0) *(f32x2*)(ST + (size_t)row * 2) = (f32x2){mean, rstd};
    }
}

constexpr int GP_QB = 0, GP_KB = 17408, GP_KF = 34816, GP_VF = 67840, GP_LM = 100864, GP_BETA = 117248, GP_G = 117504, GP_EG = 117760, GP_BEK = 118016;
DI bf16x8 lds_frag16(const LAS unsigned char* p) { return *(const LAS bf16x8*)p; }
DI void gdn_prep_item(LAS unsigned char* lds, const Ctx& c, int l, int item) {
    int tid = threadIdx.x; asm volatile("" : "+v"(tid)); const int lane = tid & 63, wave = __builtin_amdgcn_readfirstlane(tid >> 6);
    const int h = item & 3, n = (item >> 2) & 127, b = item >> 9;
    const int tok0 = b * SEQ + n * 64;
    const size_t cidx = (size_t)(b * 4 + h) * 128 + n;
    unsigned char* ws = c.ws;
    const bf16_t* QKV = (const bf16_t*)(ws + WS_QKV); const float* AB = (const float*)(ws + WS_AB);
    LAS float* betaL = (LAS float*)(lds + GP_BETA); LAS float* gL = (LAS float*)(lds + GP_G); LAS float* egL = (LAS float*)(lds + GP_EG);
    LAS float* kf = (LAS float*)(lds + GP_KF); LAS float* vf = (LAS float*)(lds + GP_VF); LAS float* Lm = (LAS float*)(lds + GP_LM);
    if (wave == 0) {
        const float bl = AB[(size_t)(tok0 + lane) * 8 + h], al = AB[(size_t)(tok0 + lane) * 8 + 4 + h];
        const float beta = sigmoidf_(bl);
        const float xx = al + c.dt_bias[l * 4 + h];
        const float e_ = __expf(-fabsf(xx));
        const float l1p = e_ < 0.01f ? e_ * (1.f - e_ * (0.5f - e_ * (1.f / 3.f))) : __logf(1.f + e_);
        const float sp = fmaxf(xx, 0.f) + l1p;
        float gv = -__expf(c.a_log[l * 4 + h]) * sp;
#pragma unroll
        for (int o = 1; o < 64; o <<= 1) { const float t = __shfl_up(gv, o); if (lane >= o) gv += t; }
        betaL[lane] = beta; gL[lane] = gv; const float eg_ = __expf(gv); egL[lane] = eg_; ((LAS float*)(lds + GP_BEK))[lane] = beta * eg_;
    }
    {
        const int cp = lane, tg = wave;
        unsigned xin[3][11]; f32x2 cwv[3][4];
#pragma unroll
        for (int which = 0; which < 3; ++which) {
            const int cb = which * 512 + h * 128 + 2 * cp;
#pragma unroll
            for (int r = 0; r < 11; ++r) { const int sl = n * 64 + 8 * tg - 3 + r; xin[which][r] = sl >= 0 ? *(const unsigned*)(QKV + (size_t)(b * SEQ + sl) * 1536 + cb) : 0u; }
#pragma unroll
            for (int j = 0; j < 4; ++j) cwv[which][j] = *(const f32x2*)(c.conv_w + (size_t)l * 4 * 1536 + cb + j * 1536);
        }
#pragma unroll
        for (int which = 0; which < 3; ++which) {
            float w0[4], w1[4];
#pragma unroll
            for (int j = 0; j < 4; ++j) { w0[j] = cwv[which][j].x; w1[j] = cwv[which][j].y; }
            float x0[11], x1[11];
#pragma unroll
            for (int r = 0; r < 11; ++r) { x0[r] = lo_bf(xin[which][r]); x1[r] = hi_bf(xin[which][r]); }
#pragma unroll
            for (int t = 0; t < 8; ++t) {
                float a0 = 0.f, a1 = 0.f;
#pragma unroll
                for (int j = 0; j < 4; ++j) { a0 += w0[j] * x0[t + j]; a1 += w1[j] * x1[t + j]; }
                a0 = siluf_(a0); a1 = siluf_(a1);
                const int tl = 8 * tg + t;
                if (which < 2) {
                    const float ss = wave_sum(a0 * a0 + a1 * a1); float rs = __builtin_amdgcn_rsqf(ss + RMS_EPS); if (which == 0) rs *= 0.08838834764831845f;
                    a0 *= rs; a1 *= rs;
                    *(LAS unsigned*)(lds + (which == 0 ? GP_QB : GP_KB) + tl * 272 + cp * 4) = pk2(a0, a1);
                    if (which == 1) { kf[tl * 129 + 2 * cp] = a0; kf[tl * 129 + 2 * cp + 1] = a1; }
                } else { vf[tl * 129 + 2 * cp] = a0; vf[tl * 129 + 2 * cp + 1] = a1; }
            }
        }
    }
    BLOCK_SYNC();
    {
        const int mat = wave >> 2, rb = wave & 3, m16 = lane & 15, g4 = lane >> 4;
        const LAS unsigned char* Ab = lds + (mat == 0 ? GP_KB : GP_QB) + (16 * rb + m16) * 272 + g4 * 16;
        bf16x8 af[4];
#pragma unroll
        for (int ks = 0; ks < 4; ++ks) af[ks] = lds_frag16(Ab + ks * 64);
        bf16_t* ATg = (bf16_t*)(ws + WS_AT) + cidx * 4096;
        for (int cb = 0; cb <= rb; ++cb) {
            f32x4 d = {0.f, 0.f, 0.f, 0.f};
            const LAS unsigned char* Bb = lds + GP_KB + (16 * cb + m16) * 272 + g4 * 16;
#pragma unroll
            for (int ks = 0; ks < 4; ++ks) d = __builtin_amdgcn_mfma_f32_16x16x32_bf16(af[ks], lds_frag16(Bb + ks * 64), d, 0, 0, 0);
            const int j = 16 * cb + m16; const float gj = gL[j];
            f32x4 lv;
#pragma unroll
            for (int r = 0; r < 4; ++r) { const int i = 16 * rb + 4 * g4 + r; const float dec = __expf(gL[i] - gj);
                if (mat == 0) lv[r] = (j < i) ? betaL[i] * d[r] * dec : 0.f;
                else ATg[i * 64 + j] = (bf16_t)(pk2((j <= i) ? d[r] * dec : 0.f, 0.f) & 0xffffu); }
            if (mat == 0) *(LAS f32x4*)(Lm + j * 64 + 16 * rb + 4 * g4) = lv;
        }
        if (mat == 1) for (int cb = rb + 1; cb < 4; ++cb) {
#pragma unroll
            for (int r = 0; r < 4; ++r) ATg[(16 * rb + 4 * g4 + r) * 64 + 16 * cb + m16] = 0; }
    }
    BLOCK_SYNC();
    if (tid < 256) {
        const int col = tid; const LAS float* src = col < 128 ? vf + col : kf + (col - 128); const LAS float* mul = col < 128 ? betaL : (LAS float*)(lds + GP_BEK);
        const LAS float* Lb = Lm; asm volatile("" : "+v"(Lb)); asm volatile("" : "+v"(mul));
        float xr[64];
#pragma unroll
        for (int i = 0; i < 64; ++i) xr[i] = src[i * 129] * mul[i];
#pragma unroll
        for (int j = 0; j < 63; ++j) {
            const float xj = xr[j];
#pragma unroll
            for (int i4 = (j + 1) / 4; i4 < 16; ++i4) { const f32x4 Lv = *(const LAS f32x4*)(Lb + j * 64 + 4 * i4);
#pragma unroll
                for (int q = 0; q < 4; ++q) xr[4 * i4 + q] -= Lv[q] * xj; }
#define PIN16(o) asm volatile("" : "+v"(xr[o]), "+v"(xr[o + 1]), "+v"(xr[o + 2]), "+v"(xr[o + 3]), "+v"(xr[o + 4]), "+v"(xr[o + 5]), "+v"(xr[o + 6]), "+v"(xr[o + 7]), "+v"(xr[o + 8]), "+v"(xr[o + 9]), "+v"(xr[o + 10]), "+v"(xr[o + 11]), "+v"(xr[o + 12]), "+v"(xr[o + 13]), "+v"(xr[o + 14]), "+v"(xr[o + 15]) :: "memory")
            PIN16(0); PIN16(16); PIN16(32); PIN16(48);
        }
        if (col < 128) {
            bf16_t* U = (bf16_t*)(ws + WS_UC) + cidx * 8192; const int cw = col >> 5, nn = col & 31;
#pragma unroll
            for (int mt = 0; mt < 2; ++mt)
#pragma unroll
                for (int j = 0; j < 4; ++j)
#pragma unroll
                    for (int g = 0; g < 2; ++g) { const int t0 = 32 * mt + 8 * j + 4 * g; u32x2 v; v.x = pk2(xr[t0], xr[t0 + 1]); v.y = pk2(xr[t0 + 2], xr[t0 + 3]);
                        *(u32x2*)(U + ((cw * 64 + 32 * g + nn) * 32 + 16 * mt + 4 * j)) = v; }
        } else {
            bf16_t* Wg = (bf16_t*)(ws + WS_WC) + cidx * 8192 + (col - 128);
#pragma unroll
            for (int i = 0; i < 64; ++i) Wg[i * 128] = (bf16_t)(pk2(xr[i], 0.f) & 0xffffu);
        }
    } else {
        const int t2 = tid - 256, l2 = t2 & 63, w2 = t2 >> 6;
        bf16_t* QDg = (bf16_t*)(ws + WS_QD) + cidx * 8192; bf16_t* KDg = (bf16_t*)(ws + WS_KDT) + cidx * 8192;
        const float glast = gL[63];
        for (int i = w2 * 16; i < w2 * 16 + 16; ++i) { const unsigned v = *(const LAS unsigned*)(lds + GP_QB + i * 272 + l2 * 4); const float e = egL[i];
            *(unsigned*)(QDg + i * 128 + 2 * l2) = pk2(lo_bf(v) * e, hi_bf(v) * e); }
        const float ek = __expf(glast - gL[l2]);
        for (int d = w2 * 32; d < w2 * 32 + 32; ++d) KDg[d * 64 + l2] = (bf16_t)(pk2(kf[l2 * 129 + d] * ek, 0.f) & 0xffffu);
        if (t2 == 0) ((float*)(ws + WS_GL))[cidx] = __expf(glast);
    }
    BLOCK_SYNC();
}

constexpr int SC_W = 0, SC_WSZ = 64 * 264, SC_Q = SC_WSZ, SC_K = 2 * SC_WSZ, SC_A = SC_K + 128 * 136, SC_BUF = SC_A + 64 * 136, SC_O = 2 * SC_BUF, SC_OSZ = 64 * 272;
DI bf16x8 lds_frag8x2(const LAS unsigned char* p) {
    const s16x4 a = *(const LAS s16x4*)p, b = *(const LAS s16x4*)(p + 32);
    return __builtin_shufflevector(a, b, 0, 1, 2, 3, 4, 5, 6, 7);
}
DI bf16x8 lds_frag32(const LAS unsigned char* p) {
    const s16x4 a = *(const LAS s16x4*)p, b = *(const LAS s16x4*)(p + 16);
    return __builtin_shufflevector(a, b, 0, 1, 2, 3, 4, 5, 6, 7);
}
DI bf16x8 pack_b(f32x4 a, f32x4 b) { return __builtin_bit_cast(bf16x8, pack8(a, b)); }
DI bf16x8 pack_h(const f32x16& x, int h8) {
    u32x4 w; w.x = pk2(x[8 * h8 + 0], x[8 * h8 + 1]); w.y = pk2(x[8 * h8 + 2], x[8 * h8 + 3]); w.z = pk2(x[8 * h8 + 4], x[8 * h8 + 5]); w.w = pk2(x[8 * h8 + 6], x[8 * h8 + 7]);
    return __builtin_bit_cast(bf16x8, w);
}
#define SC_RAW_BARRIER() do { asm volatile("s_waitcnt lgkmcnt(0)" ::: "memory"); __builtin_amdgcn_s_barrier(); asm volatile("" ::: "memory"); } while (0)
struct ScanH {
    const bf16_t *WC, *QD, *KD, *AT, *Zg; bf16_t* MIX; LAS unsigned char* lds; int b, h, ht, pt, pseg;
};
DI void sh_load(const ScanH& k, int nc, u32x4 (&st)[14]) {
    const size_t o8 = (size_t)nc * 8192; const int ht = k.ht;
#pragma unroll
    for (int i = 0; i < 4; ++i) { const int id = ht + 256 * i, r = id >> 4, cc = id & 15; st[i] = *(const u32x4*)(k.WC + o8 + r * 128 + cc * 8); st[4 + i] = *(const u32x4*)(k.QD + o8 + r * 128 + cc * 8); }
#pragma unroll
    for (int i = 0; i < 4; ++i) { const int id = ht + 256 * i, r = id >> 3, cc = id & 7; st[8 + i] = *(const u32x4*)(k.KD + o8 + r * 64 + cc * 8); }
#pragma unroll
    for (int i = 0; i < 2; ++i) { const int id = ht + 256 * i, r = id >> 3, cc = id & 7; st[12 + i] = *(const u32x4*)(k.AT + (size_t)nc * 4096 + r * 64 + cc * 8); }
}
DI void sh_store(const ScanH& k, int bf, const u32x4 (&st)[14]) {
    LAS unsigned char* B_ = k.lds + bf * SC_BUF; const int ht = k.ht;
#pragma unroll
    for (int i = 0; i < 4; ++i) { const int id = ht + 256 * i, r = id >> 4, cc = id & 15;
        *(LAS u32x2*)(B_ + SC_W + r * 264 + cc * 16) = (u32x2){st[i].x, st[i].y}; *(LAS u32x2*)(B_ + SC_W + r * 264 + cc * 16 + 8) = (u32x2){st[i].z, st[i].w};
        *(LAS u32x2*)(B_ + SC_Q + r * 264 + cc * 16) = (u32x2){st[4 + i].x, st[4 + i].y}; *(LAS u32x2*)(B_ + SC_Q + r * 264 + cc * 16 + 8) = (u32x2){st[4 + i].z, st[4 + i].w}; }
#pragma unroll
    for (int i = 0; i < 4; ++i) { const int id = ht + 256 * i, r = id >> 3, cc = id & 7;
        *(LAS u32x2*)(B_ + SC_K + r * 136 + cc * 16) = (u32x2){st[8 + i].x, st[8 + i].y}; *(LAS u32x2*)(B_ + SC_K + r * 136 + cc * 16 + 8) = (u32x2){st[8 + i].z, st[8 + i].w}; }
#pragma unroll
    for (int i = 0; i < 2; ++i) { const int id = ht + 256 * i, r = id >> 3, cc = id & 7;
        *(LAS u32x2*)(B_ + SC_A + r * 136 + cc * 16) = (u32x2){st[12 + i].x, st[12 + i].y}; *(LAS u32x2*)(B_ + SC_A + r * 136 + cc * 16 + 8) = (u32x2){st[12 + i].z, st[12 + i].w}; }
}
DI void sh_load_z(const ScanH& k, int nc, u32x4 (&zz)[4]) {
    const bf16_t* zp = k.Zg + (size_t)(k.b * SEQ + nc * 64 + k.pt) * 512 + k.h * 128 + 32 * k.pseg;
#pragma unroll
    for (int i = 0; i < 4; ++i) zz[i] = *(const u32x4*)(zp + 8 * i);
}
DI void scan_helper_step(const ScanH& k, int n, u32x4 (&stL)[14], const u32x4 (&stS)[14], u32x4 (&zL)[4], const u32x4 (&zz)[4]) {
    LAS unsigned char* lds = k.lds; const int bf = n & 1, tokb = k.b * SEQ + n * 64;
    sh_load_z(k, n + 1 < 128 ? n + 1 : 127, zL);
    sh_load(k, n + 2 < 128 ? n + 2 : 127, stL);
    sh_store(k, bf ^ 1, stS);
    SC_RAW_BARRIER();
    const LAS unsigned char* ob = lds + SC_O + bf * SC_OSZ + k.pt * 272 + k.pseg * 64;
    const LAS float* gmL = (const LAS float*)(lds + SC_O + 2 * SC_OSZ + 512) + 32 * k.pseg;
    u32x4 ov4[4];
#pragma unroll
    for (int i = 0; i < 4; ++i) ov4[i] = *(const LAS u32x4*)(ob + 16 * i);
    float ss = 0.f;
#pragma unroll
    for (int i = 0; i < 4; ++i)
#pragma unroll
        for (int j = 0; j < 4; ++j) { const float a = lo_bf(ov4[i][j]), b2 = hi_bf(ov4[i][j]); ss += a * a + b2 * b2; }
    ss += __shfl_xor(ss, 1); ss += __shfl_xor(ss, 2);
    const float rs = __builtin_amdgcn_rsqf(ss * (1.f / 128.f) + RMS_EPS);
    bf16_t* mp = k.MIX + (size_t)(tokb + k.pt) * DM + k.h * 128 + 32 * k.pseg;
#pragma unroll
    for (int i = 0; i < 4; ++i) { u32x4 res;
#pragma unroll
        for (int j = 0; j < 4; ++j) { const int e = 8 * i + 2 * j;
            const float a0 = lo_bf(ov4[i][j]) * rs * gmL[e] * lo_bf(zz[i][j]), a1 = hi_bf(ov4[i][j]) * rs * gmL[e + 1] * hi_bf(zz[i][j]); res[j] = pk2(a0, a1); }
        *(u32x4*)(mp + 8 * i) = res; }
}
DI void scan_compute_step(LAS unsigned char* lds, int n, int cw, int lane, const bf16_t* UCl, f32x16 (&S)[4], u32x4 (&ucur)[4]) {
    const int g = lane >> 5, m = lane & 31, bf = n & 1;
    u32x4 un[4];
    { const bf16_t* up = UCl + (size_t)(n + 1 < 128 ? n + 1 : 127) * 8192;
#pragma unroll
      for (int i = 0; i < 4; ++i) un[i] = *(const u32x4*)(up + 8 * i); }
    const float egl = ((const LAS float*)(lds + SC_O + 2 * SC_OSZ))[n];
    const LAS unsigned char* Bf = lds + bf * SC_BUF;
    const LAS unsigned char* pW = Bf + SC_W + m * 264 + g * 8;
    const LAS unsigned char* pA = Bf + SC_A + m * 136 + g * 8;
    bf16x8 Sb[8];
#pragma unroll
    for (int s = 0; s < 8; ++s) Sb[s] = pack_h(S[s >> 1], s & 1);
    f32x16 vt[2], o[2];
    bf16x8 fA[4], fB[4];
#define SCHED_FENCE() __builtin_amdgcn_sched_barrier(0)
#define LDF(dst, p, rowstep, mt, s0) do { _Pragma("unroll") for (int i_ = 0; i_ < 4; ++i_) dst[i_] = lds_frag32((p) + (mt) * 32 * (rowstep) + ((s0) + i_) * 32); } while (0)
#define MMZ(acc, src, s0, first) do { _Pragma("unroll") for (int i_ = 0; i_ < 4; ++i_) acc = __builtin_amdgcn_mfma_f32_32x32x16_bf16(src[i_], Sb[(s0) + i_], acc, 0, 0, 0); } while (0)
#define MMV(acc, src) do { _Pragma("unroll") for (int i_ = 0; i_ < 4; ++i_) acc = __builtin_amdgcn_mfma_f32_32x32x16_bf16(src[i_], Vb[i_], acc, 0, 0, 0); } while (0)
#pragma unroll
    for (int r = 0; r < 16; ++r) { vt[0][r] = 0.f; vt[1][r] = 0.f; o[0][r] = 0.f; o[1][r] = 0.f; }
    LDF(fA, pW, 264, 0, 0); SCHED_FENCE();
    LDF(fB, pW, 264, 0, 4); MMZ(vt[0], fA, 0, 1); SCHED_FENCE();
    LDF(fA, pW, 264, 1, 0); MMZ(vt[0], fB, 4, 0); SCHED_FENCE();
    LDF(fB, pW, 264, 1, 4); MMZ(vt[1], fA, 0, 1); SCHED_FENCE();
    LDF(fA, pW + SC_Q, 264, 0, 0); MMZ(vt[1], fB, 4, 0); SCHED_FENCE();
    LDF(fB, pW + SC_Q, 264, 0, 4); MMZ(o[0], fA, 0, 1); SCHED_FENCE();
    LDF(fA, pW + SC_Q, 264, 1, 0); MMZ(o[0], fB, 4, 0); SCHED_FENCE();
    LDF(fB, pW + SC_Q, 264, 1, 4); MMZ(o[1], fA, 0, 1); SCHED_FENCE();
    LDF(fA, pA, 136, 0, 0); MMZ(o[1], fB, 4, 0);
#pragma unroll
    for (int mt = 0; mt < 2; ++mt)
#pragma unroll
        for (int q = 0; q < 8; ++q) { const unsigned uu = ucur[2 * mt + (q >> 2)][q & 3]; vt[mt][2 * q] = lo_bf(uu) - vt[mt][2 * q]; vt[mt][2 * q + 1] = hi_bf(uu) - vt[mt][2 * q + 1]; }
    bf16x8 Vb[4];
#pragma unroll
    for (int s = 0; s < 4; ++s) Vb[s] = pack_h(vt[s >> 1], s & 1);
    SCHED_FENCE();
    LDF(fB, pA, 136, 1, 0); MMV(o[0], fA); SCHED_FENCE();
    LDF(fA, pA + (SC_K - SC_A), 136, 0, 0); MMV(o[1], fB); SCHED_FENCE();
#pragma unroll
    for (int mt = 0; mt < 4; ++mt)
#pragma unroll
        for (int r = 0; r < 16; ++r) S[mt][r] *= egl;
    LDF(fB, pA + (SC_K - SC_A), 136, 1, 0); MMV(S[0], fA); SCHED_FENCE();
    LDF(fA, pA + (SC_K - SC_A), 136, 2, 0); MMV(S[1], fB); SCHED_FENCE();
    LDF(fB, pA + (SC_K - SC_A), 136, 3, 0); MMV(S[2], fA); SCHED_FENCE();
    MMV(S[3], fB); SCHED_FENCE();
#undef LDF
#undef MMZ
#undef MMV
    {
        LAS unsigned char* ob = lds + SC_O + bf * SC_OSZ + (4 * g) * 272 + (32 * cw + m) * 2;
#pragma unroll
        for (int mt = 0; mt < 2; ++mt)
#pragma unroll
            for (int r = 0; r < 16; ++r) *(LAS bf16_t*)(ob + (32 * mt + 8 * (r >> 2) + (r & 3)) * 272) = (bf16_t)(pk2(o[mt][r], 0.f) & 0xffffu);
    }
    SC_RAW_BARRIER();
#pragma unroll
    for (int i = 0; i < 4; ++i) ucur[i] = un[i];
}
DI void scan_item(LAS unsigned char* lds, const Ctx& c, int l, int bh) {
    int tid = threadIdx.x; asm volatile("" : "+v"(tid));
    const int lane = tid & 63, w = __builtin_amdgcn_readfirstlane(tid >> 6);
    const int b = bh >> 2, h = bh & 3;
    unsigned char* ws = c.ws;
    const float* GL = (const float*)(ws + WS_GL) + bh * 128;
    LAS float* glL = (LAS float*)(lds + SC_O + 2 * SC_OSZ);
    if (tid < 128) { glL[tid] = GL[tid]; glL[128 + tid] = c.gdn_g[l * 128 + tid]; }
    if (w >= 4) {
        ScanH k; k.lds = lds; k.b = b; k.h = h; k.ht = tid - 256; k.pt = k.ht >> 2; k.pseg = k.ht & 3;
        k.WC = (const bf16_t*)(ws + WS_WC) + (size_t)bh * 128 * 8192; k.QD = (const bf16_t*)(ws + WS_QD) + (size_t)bh * 128 * 8192;
        k.KD = (const bf16_t*)(ws + WS_KDT) + (size_t)bh * 128 * 8192; k.AT = (const bf16_t*)(ws + WS_AT) + (size_t)bh * 128 * 4096;
        k.Zg = (const bf16_t*)(ws + WS_Z); k.MIX = (bf16_t*)(ws + WS_MIXIN);
        u32x4 stA[14], stB[14], z0[4], z1[4];
        sh_load(k, 0, stA); sh_store(k, 0, stA);
        sh_load_z(k, 0, z0);
        sh_load(k, 1, stB);
        BLOCK_SYNC();
        for (int n = 0; n < 128; n += 2) {
            scan_helper_step(k, n, stA, stB, z1, z0);
            scan_helper_step(k, n + 1, stB, stA, z0, z1);
        }
    } else {
        const bf16_t* UCl = (const bf16_t*)(ws + WS_UC) + (size_t)bh * 128 * 8192 + (size_t)(w * 64 + lane) * 32;
        f32x16 S[4];
#pragma unroll
        for (int i = 0; i < 4; ++i)
#pragma unroll
            for (int r = 0; r < 16; ++r) S[i][r] = 0.f;
        u32x4 ucur[4];
#pragma unroll
        for (int i = 0; i < 4; ++i) ucur[i] = *(const u32x4*)(UCl + 8 * i);
        BLOCK_SYNC();
        for (int n = 0; n < 128; ++n) scan_compute_step(lds, n, w, lane, UCl, S, ucur);
    }
    BLOCK_SYNC();
}

constexpr int AT_K = 0, AT_KSZ = 64 * 400, AT_V = 2 * AT_KSZ, AT_VSZ = 128 * 136;
DI void attn_item(LAS unsigned char* lds, const Ctx& c, int bh, int qb) {
    int tid = threadIdx.x; asm volatile("" : "+v"(tid)); const int lane = tid & 63, w = __builtin_amdgcn_readfirstlane(tid >> 6), g = lane >> 5, q = lane & 31;
    const int b = bh >> 2, h = bh & 3;
    unsigned char* ws = c.ws;
    const bf16_t* QM = (const bf16_t*)(ws + WS_QM) + (size_t)bh * SEQ * 192; const bf16_t* KN = (const bf16_t*)(ws + WS_KN) + (size_t)bh * SEQ * 128;
    const bf16_t* KR = (const bf16_t*)(ws + WS_KR) + (size_t)b * SEQ * 64; const bf16_t* VT = (const bf16_t*)(ws + WS_VT) + (size_t)bh * 128 * SEQ;
    bf16_t* MIX = (bf16_t*)(ws + WS_MIXIN);
    const int srow = qb * 256 + 32 * w + q;
    bf16x8 qf[12];
#pragma unroll
    for (int t = 0; t < 12; ++t) qf[t] = *(const bf16x8*)(QM + (size_t)srow * 192 + 16 * t + 8 * g);
    f32x16 oacc[4];
    { float z_; asm volatile("v_mov_b32 %0, 0" : "=v"(z_));
#pragma unroll
      for (int i = 0; i < 4; ++i)
#pragma unroll
        for (int r = 0; r < 16; ++r) oacc[i][r] = z_; }
    float m_run = -1e30f, l_run = 0.f;
    const int ntile = 4 * qb + 4, my_last = 4 * qb + (w >> 1);
    u32x4 sk[3], sv[2];
    int kr_[3], kc_[3];
#pragma unroll
    for (int i = 0; i < 3; ++i) { const int id = tid + 512 * i; kr_[i] = id / 24; kc_[i] = id % 24; }
    const int vr0 = tid >> 3, vc = tid & 7;
#define AT_LOAD(kt) do { const int k0_ = (kt) * 64; \
        _Pragma("unroll") for (int i = 0; i < 3; ++i) sk[i] = kc_[i] < 16 ? *(const u32x4*)(KN + (size_t)(k0_ + kr_[i]) * 128 + kc_[i] * 8) : *(const u32x4*)(KR + (size_t)(k0_ + kr_[i]) * 64 + (kc_[i] - 16) * 8); \
        sv[0] = *(const u32x4*)(VT + (size_t)vr0 * SEQ + k0_ + vc * 8); sv[1] = *(const u32x4*)(VT + (size_t)(vr0 + 64) * SEQ + k0_ + vc * 8); } while (0)
#define AT_STORE(bf) do { LAS unsigned char* K_ = lds + AT_K + (bf) * AT_KSZ; LAS unsigned char* V_ = lds + AT_V + (bf) * AT_VSZ; \
        _Pragma("unroll") for (int i = 0; i < 3; ++i) *(LAS u32x4*)(K_ + kr_[i] * 400 + kc_[i] * 16) = sk[i]; \
        *(LAS u32x2*)(V_ + vr0 * 136 + vc * 16) = (u32x2){sv[0].x, sv[0].y}; *(LAS u32x2*)(V_ + vr0 * 136 + vc * 16 + 8) = (u32x2){sv[0].z, sv[0].w}; \
        *(LAS u32x2*)(V_ + (vr0 + 64) * 136 + vc * 16) = (u32x2){sv[1].x, sv[1].y}; *(LAS u32x2*)(V_ + (vr0 + 64) * 136 + vc * 16 + 8) = (u32x2){sv[1].z, sv[1].w}; } while (0)
    AT_LOAD(0); AT_STORE(0);
    BLOCK_SYNC();
    for (int kt = 0; kt < ntile; ++kt) {
        const int bf = kt & 1;
        if (kt + 1 < ntile) AT_LOAD(kt + 1);
        if (kt <= my_last) {
            const LAS unsigned char* Kb = lds + AT_K + bf * AT_KSZ; const LAS unsigned char* Vb = lds + AT_V + bf * AT_VSZ;
            f32x16 s0, s1;
#pragma unroll
            for (int r = 0; r < 16; ++r) { s0[r] = 0.f; s1[r] = 0.f; }
#pragma unroll
            for (int t = 0; t < 12; ++t) {
                const bf16x8 k0 = *(const LAS bf16x8*)(Kb + q * 400 + (16 * t + 8 * g) * 2);
                const bf16x8 k1 = *(const LAS bf16x8*)(Kb + (32 + q) * 400 + (16 * t + 8 * g) * 2);
                s0 = __builtin_amdgcn_mfma_f32_32x32x16_bf16(k0, qf[t], s0, 0, 0, 0);
                s1 = __builtin_amdgcn_mfma_f32_32x32x16_bf16(k1, qf[t], s1, 0, 0, 0);
            }
            float mx = s0[0];
#pragma unroll
            for (int r = 1; r < 16; ++r) mx = fmaxf(mx, s0[r]);
#pragma unroll
            for (int r = 0; r < 16; ++r) mx = fmaxf(mx, s1[r]);
            mx = fmaxf(mx, __shfl_xor(mx, 32));
            const float m_new = fmaxf(m_run, mx), alpha = __builtin_amdgcn_exp2f(m_run - m_new);
            float ps = 0.f;
#pragma unroll
            for (int r = 0; r < 16; ++r) { s0[r] = __builtin_amdgcn_exp2f(s0[r] - m_new); s1[r] = __builtin_amdgcn_exp2f(s1[r] - m_new); ps += s0[r] + s1[r]; }
            l_run = l_run * alpha + ps; m_run = m_new;
#pragma unroll
            for (int i = 0; i < 4; ++i)
#pragma unroll
                for (int r = 0; r < 16; ++r) oacc[i][r] *= alpha;
#pragma unroll
            for (int t = 0; t < 4; ++t) { const f32x16& sx = (t < 2) ? s0 : s1; const int o8 = 8 * (t & 1); u32x4 pw;
                pw.x = pk2(sx[o8 + 0], sx[o8 + 1]); pw.y = pk2(sx[o8 + 2], sx[o8 + 3]); pw.z = pk2(sx[o8 + 4], sx[o8 + 5]); pw.w = pk2(sx[o8 + 6], sx[o8 + 7]); const bf16x8 pb = __builtin_bit_cast(bf16x8, pw);
#pragma unroll
                for (int md = 0; md < 4; ++md) {
                    const LAS unsigned char* vp = Vb + (32 * md + q) * 136 + (16 * t + 4 * g) * 2;
                    const s16x4 a = *(const LAS s16x4*)vp, bb = *(const LAS s16x4*)(vp + 16);
                    oacc[md] = __builtin_amdgcn_mfma_f32_32x32x16_bf16(__builtin_shufflevector(a, bb, 0, 1, 2, 3, 4, 5, 6, 7), pb, oacc[md], 0, 0, 0);
                } }
        }
        if (kt + 1 < ntile) AT_STORE(bf ^ 1);
        BLOCK_SYNC();
    }
    l_run += __shfl_xor(l_run, 32);
    const float inv = 1.f / l_run;
    bf16_t* op = MIX + (size_t)(b * SEQ + srow) * DM + 512 + h * 128;
#pragma unroll
    for (int md = 0; md < 4; ++md)
#pragma unroll
        for (int j = 0; j < 4; ++j) { u32x2 v; v.x = pk2(oacc[md][4 * j] * inv, oacc[md][4 * j + 1] * inv); v.y = pk2(oacc[md][4 * j + 2] * inv, oacc[md][4 * j + 3] * inv);
            *(u32x2*)(op + 32 * md + 8 * j + 4 * g) = v; }
#undef AT_LOAD
#undef AT_STORE
}

DI void phase_p3(LAS unsigned char* lds, const Ctx& c, int l, int cslot) {
    (void)cslot;
    unsigned* ctr = (unsigned*)(c.ws + WS_CTR) + l * 8;
    const unsigned xid = (unsigned)__builtin_amdgcn_s_getreg((3 << 11) | 20) & 7u;
    volatile LAS int* slot = (volatile LAS int*)(lds + LDS_CTL);
    for (;;) {
        if (threadIdx.x == 0) {
            int item = -1;
            for (unsigned d = 0; d < 8u; ++d) { const unsigned qx = (xid + d) & 7u; const unsigned i = atomicAdd(ctr + qx, 1u); if (i < 66u) { item = (int)(qx * 66u + i); break; } }
            slot[0] = item;
        }
        BLOCK_SYNC();
        const int it = slot[0];
        BLOCK_SYNC();
        if (it < 0) break;
        const int qx = it / 66, i = it % 66;
        if (i < 2) scan_item(lds, c, l, 2 * qx + i);
        else { const int idx = i - 2; attn_item(lds, c, 2 * qx + (idx & 1), 31 - (idx >> 1)); }
    }
}

#define XB_TMO      128
#define XB_XCNT(j)  (256  + 64 * (j))
#define XB_XSUB(j)  (1280 + 64 * (j))
#define XB_XGEN(j)  (2304 + 64 * (j))
#define XB_TOP      3328
#define XB_TOPGEN   3392
#define XCD_BAR_WORDS 3456
#define XB_SPIN_CAP (1u << 18)

__device__ __forceinline__ unsigned xb_ld(unsigned* p)              { return __hip_atomic_load(p, __ATOMIC_RELAXED, __HIP_MEMORY_SCOPE_AGENT); }
__device__ __forceinline__ unsigned xb_add(unsigned* p, unsigned v) { return __hip_atomic_fetch_add(p, v, __ATOMIC_RELAXED, __HIP_MEMORY_SCOPE_AGENT); }
__device__ __forceinline__ unsigned xb_xcc_id() { return (unsigned)__builtin_amdgcn_s_getreg((3 << 11) | 20) & 0xFu; }
#define XB_SPIN(cond, bar) do { unsigned _sp = 0; while (cond) { __builtin_amdgcn_s_sleep(1); \
    if ((++_sp & 255u) == 0u) { if (xb_ld(&(bar)[XB_TMO])) break; if (_sp > XB_SPIN_CAP) { atomicAdd(&(bar)[XB_TMO], 1u); break; } } } } while (0)

struct XcdBarrier {
    unsigned* bar; unsigned x;
    volatile LAS unsigned* st;
};

__device__ __forceinline__ XcdBarrier xcd_barrier_post(unsigned* bar, volatile LAS unsigned* st) {
    XcdBarrier b; b.bar = bar; b.x = xb_xcc_id(); b.st = st;
    if (threadIdx.x == 0) (void)xb_add(&bar[XB_XCNT(b.x)], 1u);
    return b;
}
__device__ __forceinline__ void xcd_barrier_complete(unsigned* bar, unsigned x, unsigned& nloc, unsigned& nx) {
    const unsigned G = gridDim.x * gridDim.y * gridDim.z;
    unsigned sum, cnt, mine, sp = 0u;
    for (;;) {
        sum = 0u; cnt = 0u; mine = 0u;
#pragma unroll
        for (unsigned j = 0; j < 16; ++j) { const unsigned c = xb_ld(&bar[XB_XCNT(j)]); sum += c; cnt += (c > 0u) ? 1u : 0u; mine = (j == x) ? c : mine; }
        if (sum == G) break;
        __builtin_amdgcn_s_sleep(1);
        if ((++sp & 255u) == 0u) { if (xb_ld(&bar[XB_TMO])) break; if (sp > XB_SPIN_CAP) { atomicAdd(&bar[XB_TMO], 1u); break; } }
    }
    nloc = mine > 0u ? mine : 1u; nx = cnt > 0u ? cnt : 1u;
}

__device__ __forceinline__ void xcd_barrier(const XcdBarrier& b) {
    asm volatile("s_waitcnt vmcnt(0)" ::: "memory");
    __syncthreads();
    if (threadIdx.x == 0) {
        unsigned* bar = b.bar;
        __builtin_amdgcn_s_waitcnt(0);
        unsigned nloc = b.st[0], nx = b.st[1];
        if (nloc == 0u) { xcd_barrier_complete(bar, b.x, nloc, nx); b.st[0] = nloc; b.st[1] = nx; }
        const unsigned old = xb_add(&bar[XB_XSUB(b.x)], 1u);
        const unsigned gen = old / nloc;
        if (old + 1u == (gen + 1u) * nloc) {
            __builtin_amdgcn_fence(__ATOMIC_RELEASE, "agent");
            asm volatile("s_waitcnt vmcnt(0)" ::: "memory");
            const unsigned og = xb_add(&bar[XB_TOP], 1u);
            const unsigned tg = og / nx;
            if (og + 1u == (tg + 1u) * nx) xb_add(&bar[XB_TOPGEN], 1u);
            else XB_SPIN(xb_ld(&bar[XB_TOPGEN]) == tg, bar);
            __builtin_amdgcn_fence(__ATOMIC_ACQUIRE, "agent");
            xb_add(&bar[XB_XGEN(b.x)], 1u);
            asm volatile("s_waitcnt vmcnt(0)" ::: "memory");
        } else {
            XB_SPIN(xb_ld(&bar[XB_XGEN(b.x)]) == gen, bar);
            __builtin_amdgcn_fence(__ATOMIC_ACQUIRE, "agent");
            asm volatile("s_waitcnt vmcnt(0)" ::: "memory");
        }
    }
    __syncthreads();
}

template <int KP> __global__ void __launch_bounds__(NT, 2) fwd_kernel(Args args) {
    extern __shared__ __attribute__((aligned(16))) unsigned char lds_raw[];
    LAS unsigned char* lds = (LAS unsigned char*)lds_raw;
    cg::grid_group grid = cg::this_grid();
    if (threadIdx.x < 8) ((volatile LAS unsigned*)(lds + LDS_CTL))[threadIdx.x] = 0u;
    __syncthreads();
    typedef const __attribute__((address_space(4))) Args* ArgsP;
    const ArgsP ap0 = (ArgsP)__builtin_amdgcn_kernarg_segment_ptr();
    const int ph_lo = ap0->ph_lo, ph_hi = ap0->ph_hi;
    XcdBarrier xbar = xcd_barrier_post((unsigned*)(ap0->ws + WS_BAR), (volatile LAS unsigned*)(lds + LDS_CTL + 16));
    for (int ph = ph_lo; ph < ph_hi; ++ph) {
        const int l = ph / PH_PER_LAYER, k = ph % PH_PER_LAYER;
        ArgsP ap = ap0; asm volatile("" : "+s"(ap));
        Ctx c;
        c.x = (const float*)ap->in[0]; c.p = (const float*)ap->in[1]; c.pos = (const int*)ap->in[2]; c.w_in = (const float*)ap->in[3]; c.conv_w = (const float*)ap->in[4];
        c.a_log = (const float*)ap->in[5]; c.dt_bias = (const float*)ap->in[6]; c.gdn_g = (const float*)ap->in[7]; c.qn_g = (const float*)ap->in[8]; c.w_uq = (const float*)ap->in[9];
        c.kvn_g = (const float*)ap->in[10]; c.w_ukv = (const float*)ap->in[11]; c.w_out = (const float*)ap->in[12]; c.ln1_g = (const float*)ap->in[13]; c.ln1_b = (const float*)ap->in[14];
        c.w_gu = (const float*)ap->in[15]; c.w_dn = (const float*)ap->in[16]; c.ln2_g = (const float*)ap->in[17]; c.ln2_b = (const float*)ap->in[18]; c.w_ple = (const float*)ap->in[19]; c.w_pg = (const float*)ap->in[20];
        c.out = ap->out; c.ws = ap->ws;
        unsigned char* ws = c.ws;
        const float* xres = l == 0 ? c.x : c.out;
        if constexpr (KP >= 0) { if (k != KP) continue; }
        switch (k) {
        case 0: phase_p0(lds, c, l);
#ifdef DUP_P0
                phase_p0(lds, c, l);
#endif
                break;
        case 1: asm volatile("; MARK_CASE_1"); { EpiIn E{ws};
                  run_gemm(lds, (const bf16_t*)(ws + WS_XB), (const bf16_t*)(ws + W_IN), T, NIN, 1024, E); } break;
        case 2: { EpiQ EQ{ws}; run_gemm(lds, (const bf16_t*)(ws + WS_CQ), (const bf16_t*)(ws + W_UQ), T, 768, 384, EQ);
#ifdef DUP_P2G
                  run_gemm(lds, (const bf16_t*)(ws + WS_CQ), (const bf16_t*)(ws + W_UQ), T, 768, 384, EQ);
#endif
                  } break;
        case 3: { EpiKV EK{ws}; run_gemm(lds, (const bf16_t*)(ws + WS_CKV), (const bf16_t*)(ws + W_UKV), T, 1024, 256, EK);
#ifdef DUP_P2G
                  run_gemm(lds, (const bf16_t*)(ws + WS_CKV), (const bf16_t*)(ws + W_UKV), T, 1024, 256, EK);
#endif
                  } break;
        case 4: for (int it = blockIdx.x; it < 2048; it += gridDim.x) gdn_prep_item(lds, c, l, it);
#ifdef DUP_PREP
                for (int it = blockIdx.x; it < 2048; it += gridDim.x) gdn_prep_item(lds, c, l, it);
#endif
                break;
        case 5: phase_p3(lds, c, l, l); break;
        case 6: { EpiOut E{xres, ws, c.ln1_g + l * DM}; run_gemm(lds, (const bf16_t*)(ws + WS_MIXIN), (const bf16_t*)(ws + W_OUT), T, 1024, 1024, E); } break;
        case 7: { EpiSwiGLU E{ws, (const float*)(ws + WS_GW) + (size_t)l * GW_LAYER}; run_gemm(lds, (const bf16_t*)(ws + WS_X1B), (const bf16_t*)(ws + W_GU), T, 2 * DFF, 1024, E); } break;
        case 8: { EpiDown E{ws, c.ln1_g + l * DM, c.ln1_b + l * DM, c.ln2_g + l * DM}; run_gemm(lds, (const bf16_t*)(ws + WS_HID), (const bf16_t*)(ws + W_DN), T, 1024, DFF, E); } break;
        case 9: { EpiE E1{ws}; run_gemm(lds, (const bf16_t*)(ws + WS_PB), (const bf16_t*)(ws + W_PLE), T, 1024, 256, E1); } break;
        default: { EpiPle E2{ws, c.ln2_g + l * DM, c.ln2_b + l * DM, c.out, (const float*)(ws + WS_GW) + (size_t)l * GW_LAYER + 2 * 5632}; run_gemm(lds, (const bf16_t*)(ws + WS_X1B), (const bf16_t*)(ws + W_PG), T, 1024, 1024, E2); } break;
        }
        if (ph + 1 < ph_hi && k != 2 && k != 3 && k != 9) { if (ph == 0) grid.sync(); else xcd_barrier(xbar); }
    }
}


#ifndef MEGA
#define MEGA 1
#endif
typedef void (*KernT)(Args);
#if !MEGA
static KernT phase_kernel(int k) {
    switch (k) { case 0: return fwd_kernel<0>; case 1: return fwd_kernel<1>; case 2: return fwd_kernel<2>; case 3: return fwd_kernel<3>; case 4: return fwd_kernel<4>; case 5: return fwd_kernel<5>;
                 case 6: return fwd_kernel<6>; case 7: return fwd_kernel<7>; case 8: return fwd_kernel<8>; case 9: return fwd_kernel<9>; default: return fwd_kernel<10>; }
}
#endif
extern "C" void kernel_launch(void* const* d_in, const int* in_sizes, int n_in, void* d_out, int out_size, void* d_ws, size_t ws_size, hipStream_t stream) {
    static int grid = 0;
    if (grid == 0) {
        if (n_in != 21 || out_size != T * DM || ws_size < WS_END) { fprintf(stderr, "kernel_launch: unexpected problem (n_in %d out %d ws %zu, need %zu)\n", n_in, out_size, ws_size, (size_t)WS_END); grid = -1; return; }
        int dev = 0, cus = 0;
        (void)hipGetDevice(&dev); (void)hipDeviceGetAttribute(&cus, hipDeviceAttributeMultiprocessorCount, dev);
        bool ok = true;
#if MEGA
        ok = hipFuncSetAttribute((const void*)fwd_kernel<-1>, hipFuncAttributeMaxDynamicSharedMemorySize, LDS_BYTES) == hipSuccess;
#else
        for (int k = 0; k < PH_PER_LAYER; ++k) ok = ok && hipFuncSetAttribute((const void*)phase_kernel(k), hipFuncAttributeMaxDynamicSharedMemorySize, LDS_BYTES) == hipSuccess;
#endif
        if (!ok) { fprintf(stderr, "kernel_launch: hipFuncSetAttribute failed\n"); grid = -1; return; }
        (void)hipGetLastError();
        grid = cus;
    }
    if (grid < 0) return;
    Args a{};
    for (int i = 0; i < 21; ++i) a.in[i] = d_in[i];
    a.out = (float*)d_out; a.ws = (unsigned char*)d_ws;
    if (hipMemsetAsync((unsigned char*)d_ws + WS_GW, 0, (size_t)DEPTH * GW_LAYER * 4, stream) != hipSuccess || hipMemsetAsync((unsigned char*)d_ws + WS_BAR, 0, XCD_BAR_WORDS * 4, stream) != hipSuccess) { fprintf(stderr, "kernel_launch: memset of the barrier words failed\n"); return; }
#if MEGA
    a.ph_lo = 0; a.ph_hi = NPHASE;
    { void* kargs[] = {&a};
      hipError_t e = hipLaunchCooperativeKernel((const void*)fwd_kernel<-1>, dim3(grid), dim3(NT), kargs, LDS_BYTES, stream);
      if (e != hipSuccess) fprintf(stderr, "cooperative launch failed: %s (grid %d)\n", hipGetErrorString(e), grid); }
#else
    for (int ph = 0; ph < NPHASE; ++ph) {
        a.ph_lo = ph; a.ph_hi = ph + 1;
        void* kargs[] = {&a};
        hipError_t e = hipLaunchCooperativeKernel((const void*)phase_kernel(ph % PH_PER_LAYER), dim3(grid), dim3(NT), kargs, LDS_BYTES, stream);
        if (e != hipSuccess) { fprintf(stderr, "cooperative launch failed: %s (grid %d)\n", hipGetErrorString(e), grid); break; }
    }
#endif
}
```

```cpp
#include <hip/hip_runtime.h>
#include <hip/hip_cooperative_groups.h>
#include <cstdio>
#include <cstdint>
namespace cg = cooperative_groups;
#define MEGA 1
namespace pg8 {
#define PG8_LAS __attribute__((address_space(3)))
typedef unsigned short bf16_t;
typedef short bf16x8 __attribute__((ext_vector_type(8)));
typedef float f32x4 __attribute__((ext_vector_type(4)));
typedef unsigned u32x4 __attribute__((ext_vector_type(4)));
constexpr int BM = 256, BK = 64, HALF = 128, HTB = HALF * BK * 2  , STAGE_BYTES = 8 * HTB, NXCD = 8, WGM = 8;

__host__ __device__ __forceinline__ int lds_byte(int r, int c) { const int st = (r >> 4) * 2 + (c >> 5), rr = r & 15, cc = c & 31, ob = rr * 64 + cc * 2; return st * 1024 + (ob ^ (((ob >> 9) & 1) << 5)); }
__host__ __device__ __forceinline__ void stage_rc(int b, int& R, int& C) { const int st = b / 1024, sb = b % 1024, swz = sb ^ (((sb >> 9) & 1) << 5); R = (st >> 1) * 16 + swz / 64; C = (st & 1) * 32 + (swz % 64) / 2; }
__host__ __device__ __forceinline__ int perm32(int rho) { const int n = rho >> 4, i = rho & 15; return 8 * (i >> 2) + 4 * n + (i & 3); }

struct Unit { int pm, pn; };
struct Gemm { const bf16_t* A; const bf16_t* Bt; int M, N, K; };

struct StaticOrder {
    int nM, nN, nwg, G, c;
    __host__ __device__ void init(int M, int N, int G_, int c_) { nM = M / BM; nN = N / BM; nwg = nM * nN; G = G_; c = c_; }
    __host__ __device__ bool next(int i, Unit& u) const {
        const long L = (long)i * G + c; if (L >= nwg) return false;
        int wgid = (int)L; { const int q = nwg / NXCD, r = nwg % NXCD, xcd = wgid % NXCD, off = wgid / NXCD; wgid = (xcd < r ? xcd * (q + 1) : r * (q + 1) + (xcd - r) * q) + off; }
        const int nig = WGM * nN, gid = wgid / nig, fm = gid * WGM, gsz = (nM - fm) < WGM ? (nM - fm) : WGM;
        u.pm = fm + ((wgid % nig) % gsz); u.pn = (wgid % nig) / gsz; return true;
    }
    __device__ __forceinline__ void a_ready(const Unit&) const {}
    __device__ __forceinline__ void done(const Unit&) const {}
};
__device__ __forceinline__ unsigned cvt_pk_bf16(float lo, float hi) { unsigned r; asm volatile("v_cvt_pk_bf16_f32 %0, %1, %2" : "=v"(r) : "v"(lo), "v"(hi)); return r; }

template <class Epi, class Sched, bool ALIGN_EPI = false, bool SP2 = false>
__device__ __forceinline__ void gemm_phase(PG8_LAS unsigned char* lds, const Gemm g, const Sched& S, const Epi& E) {
    int tid_l = threadIdx.x; asm volatile("" : "+v"(tid_l));
    const int tid = tid_l, wid = __builtin_amdgcn_readfirstlane(tid >> 6), lane = tid & 63, wr = wid >> 2, wc = wid & 3, fr = lane & 15, fq = lane >> 4;
    const int K = g.K, nt = K / BK;
    unsigned voffA[2], voffB[2];
#pragma unroll
    for (int i = 0; i < 2; ++i) { int R, C; stage_rc(tid * 16 + i * 8192, R, C); const int Rb = Epi::PERM ? ((R & ~31) + perm32(R & 31)) : R;
        voffA[i] = (unsigned)(R * K + C) * 2u; voffB[i] = (unsigned)(Rb * K + C) * 2u; }
    const size_t kstep = (size_t)(BK * 2);
    const size_t hstep = (size_t)HALF * K * 2;
    const size_t tstep = 2 * hstep;
    const unsigned ldsw = (unsigned)wid * 1024u;
    const int aoff = lds_byte(wr * 64 + fr, fq * 8), boff = lds_byte(wc * 32 + fr, fq * 8);
#define PG8_SA(b, h) (((b) * 2 + (h)) * HTB)
#define PG8_SB(b, h) ((4 + (b) * 2 + (h)) * HTB)
#define PG8_STAGE(bufoff, gbase, voff) do { _Pragma("unroll") for (int _i = 0; _i < 2; ++_i) \
        __builtin_amdgcn_global_load_lds((const unsigned*)((const char*)(gbase) + (voff)[_i]), (PG8_LAS unsigned*)(lds + (bufoff) + ldsw + _i * 8192), 16, 0, 0); } while (0)
#define PG8_LDA(dst, b, h) do { _Pragma("unroll") for (int m = 0; m < 4; ++m) _Pragma("unroll") for (int k = 0; k < 2; ++k) dst[m][k] = *(const PG8_LAS bf16x8*)(lds + PG8_SA(b, h) + aoff + m * 2048 + k * 1024); } while (0)
#define PG8_LDB(dst, b, h) do { _Pragma("unroll") for (int n = 0; n < 2; ++n) _Pragma("unroll") for (int k = 0; k < 2; ++k) dst[n][k] = *(const PG8_LAS bf16x8*)(lds + PG8_SB(b, h) + boff + n * 2048 + k * 1024); } while (0)
#define PG8_MMA(ai, bj, At, Bt) do { __builtin_amdgcn_s_setprio(1); _Pragma("unroll") for (int m = 0; m < 4; ++m) _Pragma("unroll") for (int n = 0; n < 2; ++n) _Pragma("unroll") for (int k = 0; k < 2; ++k) \
        acc[ai][bj][m][n] = __builtin_amdgcn_mfma_f32_16x16x32_bf16(Bt[n][k], At[m][k], acc[ai][bj][m][n], 0, 0, 0); __builtin_amdgcn_s_setprio(0); } while (0)
#define PG8_WAIT_V(n) asm volatile("s_waitcnt vmcnt(" #n ")" ::: "memory")
#define PG8_WAIT_L(n) asm volatile("s_waitcnt lgkmcnt(" #n ")" ::: "memory")
#define PG8_BAR __builtin_amdgcn_s_barrier()
#define PG8_SCHED __builtin_amdgcn_sched_barrier(0)
    Unit cur, nxt; int ui = 0;
    if (!S.next(0, cur)) return;
    f32x4 acc[2][2][4][2];
#pragma unroll
    for (int a = 0; a < 2; ++a)
#pragma unroll
        for (int b = 0; b < 2; ++b)
#pragma unroll
            for (int m = 0; m < 4; ++m)
#pragma unroll
                for (int n = 0; n < 2; ++n) acc[a][b][m][n] = (f32x4){0.f, 0.f, 0.f, 0.f};
    bf16x8 At[4][2], B0[2][2], B1[2][2];
    const char* cA = (const char*)g.A + (size_t)cur.pm * tstep; const char* cB = (const char*)g.Bt + (size_t)cur.pn * tstep;
    S.a_ready(cur);
    if constexpr (SP2) {
        PG8_STAGE(PG8_SB(0, 0), cB, voffB); PG8_STAGE(PG8_SB(0, 1), cB + hstep, voffB); PG8_STAGE(PG8_SA(0, 0), cA, voffA); PG8_STAGE(PG8_SA(0, 1), cA + hstep, voffA);
        if (wr == 1) PG8_BAR;
        PG8_WAIT_V(2); PG8_BAR;
        PG8_STAGE(PG8_SB(1, 0), cB + kstep, voffB); PG8_STAGE(PG8_SA(1, 0), cA + kstep, voffA); PG8_STAGE(PG8_SB(1, 1), cB + hstep + kstep, voffB);
        PG8_WAIT_V(6); PG8_BAR;
    } else {
        PG8_STAGE(PG8_SB(0, 0), cB, voffB); PG8_STAGE(PG8_SA(0, 0), cA, voffA); PG8_STAGE(PG8_SB(0, 1), cB + hstep, voffB); PG8_STAGE(PG8_SA(0, 1), cA + hstep, voffA);
        if (wr == 1) PG8_BAR;
        PG8_WAIT_V(4); PG8_BAR;
        PG8_STAGE(PG8_SB(1, 0), cB + kstep, voffB); PG8_STAGE(PG8_SA(1, 0), cA + kstep, voffA); PG8_STAGE(PG8_SB(1, 1), cB + hstep + kstep, voffB);
        PG8_WAIT_V(6); PG8_BAR;
    }
    for (;;) {
        const bool has_next = S.next(ui + 1, nxt);
        const char* nA = has_next ? (const char*)g.A + (size_t)nxt.pm * tstep : cA; const char* nB = has_next ? (const char*)g.Bt + (size_t)nxt.pn * tstep : cB;
        for (int t = 0; t < nt; t += 2) {
            const bool last = (t == nt - 2);
            const char* a1 = cA + (size_t)(t + 1) * kstep;
            const char* a2 = last ? nA : cA + (size_t)(t + 2) * kstep; const char* b2 = last ? nB : cB + (size_t)(t + 2) * kstep;
            const char* a3 = a2 + kstep; const char* b3 = b2 + kstep;
            if (last && has_next) S.a_ready(nxt);
            if constexpr (SP2) {
            PG8_LDB(B0, 0, 0); PG8_LDB(B1, 0, 1); PG8_SCHED; PG8_LDA(At, 0, 0); PG8_STAGE(PG8_SA(1, 1), a1 + hstep, voffA);
            PG8_WAIT_V(8); PG8_WAIT_L(0); PG8_BAR; PG8_MMA(0, 0, At, B0); PG8_MMA(0, 1, At, B1); PG8_BAR; PG8_SCHED;
            PG8_LDA(At, 0, 1); PG8_STAGE(PG8_SB(0, 0), b2, voffB); PG8_STAGE(PG8_SB(0, 1), b2 + hstep, voffB); PG8_STAGE(PG8_SA(0, 0), a2, voffA);
            PG8_WAIT_V(8); PG8_WAIT_L(0); PG8_BAR; PG8_MMA(1, 0, At, B0); PG8_MMA(1, 1, At, B1); PG8_BAR; PG8_SCHED;
            PG8_LDB(B0, 1, 0); PG8_LDB(B1, 1, 1); PG8_SCHED; PG8_LDA(At, 1, 0); PG8_STAGE(PG8_SA(0, 1), a2 + hstep, voffA);
            PG8_WAIT_V(8); PG8_WAIT_L(0); PG8_BAR; PG8_MMA(0, 0, At, B0); PG8_MMA(0, 1, At, B1); PG8_BAR; PG8_SCHED;
            PG8_LDA(At, 1, 1); PG8_STAGE(PG8_SB(1, 0), b3, voffB); PG8_STAGE(PG8_SB(1, 1), b3 + hstep, voffB); PG8_STAGE(PG8_SA(1, 0), a3, voffA);
            PG8_WAIT_V(8); PG8_WAIT_L(0); PG8_BAR; PG8_MMA(1, 0, At, B0); PG8_MMA(1, 1, At, B1); PG8_BAR; PG8_SCHED;
            } else {
            PG8_LDB(B0, 0, 0); PG8_SCHED; PG8_LDA(At, 0, 0); PG8_STAGE(PG8_SA(1, 1), a1 + hstep, voffA);
            PG8_WAIT_L(8); PG8_BAR; PG8_WAIT_L(0); PG8_MMA(0, 0, At, B0); PG8_BAR; PG8_SCHED;
            PG8_LDB(B1, 0, 1); PG8_STAGE(PG8_SB(0, 0), b2, voffB);
            PG8_BAR; PG8_WAIT_L(0); PG8_MMA(0, 1, At, B1); PG8_BAR;
            PG8_LDA(At, 0, 1); PG8_STAGE(PG8_SA(0, 0), a2, voffA);
            PG8_BAR; PG8_WAIT_L(0); PG8_MMA(1, 0, At, B0); PG8_BAR; PG8_SCHED;
            PG8_STAGE(PG8_SB(0, 1), b2 + hstep, voffB);
            PG8_WAIT_V(6); PG8_BAR; PG8_MMA(1, 1, At, B1); PG8_BAR;
            PG8_LDB(B0, 1, 0); PG8_SCHED; PG8_LDA(At, 1, 0); PG8_STAGE(PG8_SA(0, 1), a2 + hstep, voffA);
            PG8_WAIT_L(8); PG8_BAR; PG8_WAIT_L(0); PG8_MMA(0, 0, At, B0); PG8_BAR; PG8_SCHED;
            PG8_LDB(B1, 1, 1); PG8_STAGE(PG8_SB(1, 0), b3, voffB);
            PG8_BAR; PG8_WAIT_L(0); PG8_MMA(0, 1, At, B1); PG8_BAR;
            PG8_LDA(At, 1, 1); PG8_STAGE(PG8_SA(1, 0), a3, voffA);
            PG8_BAR; PG8_WAIT_L(0); PG8_MMA(1, 0, At, B0); PG8_BAR; PG8_SCHED;
            PG8_STAGE(PG8_SB(1, 1), b3 + hstep, voffB);
            PG8_WAIT_V(6); PG8_BAR; PG8_MMA(1, 1, At, B1); PG8_BAR;
            }
        }
        if constexpr (ALIGN_EPI) { if (wr == 0) PG8_BAR; }
        if constexpr (!Epi::AFTER_DRAIN) { E(acc, cur, wr, wc, fr, fq); S.done(cur); }
        if (!has_next) break;
#pragma unroll
        for (int a = 0; a < 2; ++a)
#pragma unroll
            for (int b = 0; b < 2; ++b)
#pragma unroll
                for (int m = 0; m < 4; ++m)
#pragma unroll
                    for (int n = 0; n < 2; ++n) acc[a][b][m][n] = (f32x4){0.f, 0.f, 0.f, 0.f};
        cur = nxt; cA = nA; cB = nB; ++ui;
        if constexpr (ALIGN_EPI) { if (wr == 1) PG8_BAR; }
    }
    PG8_WAIT_V(0);
    if constexpr (!ALIGN_EPI) { if (wr == 0) PG8_BAR; }
    PG8_BAR;
    if constexpr (Epi::AFTER_DRAIN) { E.fused(acc, cur, wr, wc, fr, fq, lds, wid, lane); S.done(cur); }
#undef PG8_SA
#undef PG8_SB
#undef PG8_STAGE
#undef PG8_LDA
#undef PG8_LDB
#undef PG8_MMA
#undef PG8_WAIT_V
#undef PG8_WAIT_L
#undef PG8_BAR
#undef PG8_SCHED
}
}

#define LAS __attribute__((address_space(3)))
#define DI __device__ __forceinline__
typedef unsigned short bf16_t;
typedef short bf16x8 __attribute__((ext_vector_type(8)));
typedef short s16x4 __attribute__((ext_vector_type(4)));
typedef float f32x2 __attribute__((ext_vector_type(2)));
typedef float f32x4 __attribute__((ext_vector_type(4)));
typedef float f32x16 __attribute__((ext_vector_type(16)));
typedef unsigned u32x4 __attribute__((ext_vector_type(4)));
typedef unsigned u32x2 __attribute__((ext_vector_type(2)));
typedef __bf16 bf16x2_t __attribute__((ext_vector_type(2)));
using pg8::Unit;

constexpr int NB = 4, SEQ = 8192, T = NB * SEQ, DM = 1024, DEPTH = 4, NIN = 2816, NIN_SRC = 2760, DFF = 2816, NT = 512, NWAVE = 8;
constexpr float ALPHA = 1.681792830507429f;
constexpr float LN_EPS = 1e-5f, RMS_EPS = 1e-6f;
constexpr float QSCALE = 0.07216878364870322f * 1.4426950408889634f;
constexpr int LDS_BYTES = 159744, LDS_CTL = 159488;
constexpr int PH_PER_LAYER = 11, NPHASE = DEPTH * PH_PER_LAYER;

constexpr size_t MiB = 1u << 20;
constexpr size_t W_IN = 0, W_UQ = 5767168, W_UKV = 6356992, W_OUT = 6881280, W_GU = 8978432, W_DN = 20512768, W_PG = 26279936, W_PLE = 28377088;
constexpr size_t WS_GW = 28901376;
constexpr int GW_LAYER = 2 * 5632 + 2 * 1024;
constexpr size_t WS_PB = 28 * MiB, WS_COS = 44 * MiB, WS_SIN = 48 * MiB, WS_MISC = 52 * MiB;
constexpr size_t WS_AB = WS_MISC, WS_SSQ = WS_MISC + 1 * MiB, WS_ST1 = WS_SSQ + 256 * 1024, WS_ST2 = WS_ST1 + 256 * 1024, WS_GL = WS_ST2 + 256 * 1024, WS_CTR = WS_GL + 64 * 1024, WS_BAR = WS_GW + (size_t)DEPTH * GW_LAYER * 4;
constexpr size_t WS_QKV = 54 * MiB, WS_Z = 150 * MiB, WS_CQ = 182 * MiB, WS_CKV = 206 * MiB, WS_KR = 222 * MiB, WS_MIXIN = 54 * MiB, WS_HID = 54 * MiB, WS_E = 54 * MiB;
constexpr size_t WS_WC = 230 * MiB, WS_QD = 262 * MiB, WS_KDT = 294 * MiB, WS_UC = 326 * MiB, WS_AT = 358 * MiB, WS_Y = 230 * MiB;
constexpr size_t WS_QM = 374 * MiB, WS_KN = 422 * MiB, WS_VT = 454 * MiB, WS_X1B = 374 * MiB, WS_XB = 438 * MiB, WS_END = 502 * MiB;

struct Args { const void* in[21]; float* out; unsigned char* ws; int ph_lo, ph_hi; };

DI unsigned pk2(float lo, float hi) { f32x2 v = {lo, hi}; bf16x2_t b = __builtin_convertvector(v, bf16x2_t); return __builtin_bit_cast(unsigned, b); }
DI float lo_bf(unsigned u) { return __uint_as_float(u << 16); }
DI float hi_bf(unsigned u) { return __uint_as_float(u & 0xffff0000u); }
DI float bf2f(bf16_t h) { return __uint_as_float((unsigned)h << 16); }
DI u32x4 pack8(f32x4 a, f32x4 b) { u32x4 w; w.x = pk2(a[0], a[1]); w.y = pk2(a[2], a[3]); w.z = pk2(b[0], b[1]); w.w = pk2(b[2], b[3]); return w; }
DI float wave_sum(float v) {
#pragma unroll
    for (int o = 1; o < 64; o <<= 1) v += __shfl_xor(v, o);
    return v;
}
DI float sigmoidf_(float x) { return __builtin_amdgcn_rcpf(1.f + __expf(-x)); }
DI float siluf_(float x) { return x * __builtin_amdgcn_rcpf(1.f + __expf(-x)); }
#define BLOCK_SYNC() __syncthreads()

struct Ctx {
    const float *x, *p, *w_in, *conv_w, *a_log, *dt_bias, *gdn_g, *qn_g, *w_uq, *kvn_g, *w_ukv, *w_out, *ln1_g, *ln1_b, *w_gu, *w_dn, *ln2_g, *ln2_b, *w_ple, *w_pg;
    const int* pos;
    float* out; unsigned char* ws;
};


__device__ const float INV_FREQ[32] = {1.000000000e+00f, 7.498942018e-01f, 5.623413324e-01f, 4.216965139e-01f, 3.162277639e-01f, 2.371373773e-01f, 1.778279394e-01f, 1.333521456e-01f, 1.000000015e-01f, 7.498942316e-02f, 5.623413250e-02f, 4.216964915e-02f, 3.162277490e-02f, 2.371373773e-02f, 1.778279431e-02f, 1.333521400e-02f, 9.999999776e-03f, 7.498942316e-03f, 5.623413250e-03f, 4.216964822e-03f, 3.162277630e-03f, 2.371373819e-03f, 1.778279431e-03f, 1.333521446e-03f, 1.000000047e-03f, 7.498941850e-04f, 5.623413017e-04f, 4.216965172e-04f, 3.162277571e-04f, 2.371373703e-04f, 1.778279402e-04f, 1.333521504e-04f};
DI void sincos_f32(float a, float& sn, float& cs) {
    const float nf = rintf(a * 0.6366197723675814f);
    float r = fmaf(-nf, 1.570796371e+00f, a); r = fmaf(-nf, -4.371138829e-08f, r); r = fmaf(-nf, -1.776356839e-15f, r);
    const float r2 = r * r;
    const float sp = r + r * r2 * (-1.6666667163e-1f + r2 * (8.3333337680e-3f + r2 * (-1.9841270114e-4f + r2 * 2.7557314297e-6f)));
    const float cp = 1.f + r2 * (-0.5f + r2 * (4.1666667908e-2f + r2 * (-1.3888889225e-3f + r2 * (2.4801587642e-5f + r2 * -2.7557314297e-7f))));
    const int q = (int)nf & 3;
    const float s0 = (q & 1) ? cp : sp, c0 = (q & 1) ? sp : cp;
    sn = (q & 2) ? -s0 : s0; cs = ((q + 1) & 2) ? -c0 : c0;
}
DI int map_col(int kind, int n) {
    if (kind == 0) {
        if (n < 2048) return n;
        if (n < 2432) return 2056 + (n - 2048);
        if (n < 2496) { const int j = n - 2432; return 2696 + (j >> 1) + 32 * (j & 1); }
        if (n < 2504) return 2048 + (n - 2496);
        if (n < 2560) return -1;
        return 2440 + (n - 2560);
    } else if (kind == 1) {
        const int h = n / 192, d = n % 192; if (d < 128) return n; const int j = d - 128; return h * 192 + 128 + (j >> 1) + 32 * (j & 1);
    } else if (kind == 2) {
        const int t = n >> 8, r = n & 255; return r < 128 ? t * 128 + r : 2816 + t * 128 + (r - 128);
    }
    return n;
}
DI void transpose_item(const float* W, int K, int Nsrc, int Ndst, bf16_t* WT, LAS float* scr, int item, int lane, const float* kscale, int kind, const float* lg, const float* lb, float* gw, float* bw) {
    const int nblk = Ndst / 32, kb = item / nblk, nb = item % nblk, k0 = 64 * kb, n0 = 32 * nb;
    const int sc = map_col(kind, n0 + (lane & 31));
    const float* wp = W + (size_t)(k0 + (lane >> 5)) * Nsrc + (sc >= 0 ? sc : 0);
#pragma unroll
    for (int h2 = 0; h2 < 2; ++h2) { float v[16];
#pragma unroll
        for (int i = 0; i < 16; ++i) v[i] = wp[(size_t)(2 * (16 * h2 + i)) * Nsrc];
#pragma unroll
        for (int i = 0; i < 16; ++i) { const int kk = 2 * (16 * h2 + i) + (lane >> 5); float x = sc >= 0 ? v[i] : 0.f; if (kscale) x *= kscale[k0 + kk]; scr[kk * 33 + (lane & 31)] = x; } }
    asm volatile("s_waitcnt lgkmcnt(0)" ::: "memory");
    if (lg) {
        const int nl = lane & 31, hf = lane >> 5; float sg = 0.f, sb = 0.f;
#pragma unroll 8
        for (int kk = 0; kk < 32; ++kk) { const int kq = 32 * hf + kk; const float wv = lo_bf(pk2(scr[kq * 33 + nl], 0.f)); sg += lg[k0 + kq] * wv; sb += lb[k0 + kq] * wv; }
        sg += __shfl_xor(sg, 32); sb += __shfl_xor(sb, 32);
        if (hf == 0) { unsafeAtomicAdd(gw + n0 + nl, sg); unsafeAtomicAdd(bw + n0 + nl, sb); }
    }
    const int c = lane & 7;
#pragma unroll
    for (int j = 0; j < 4; ++j) { const int n = (lane >> 3) + 8 * j; const LAS float* s = scr + (8 * c) * 33 + n;
        u32x4 o; o.x = pk2(s[0 * 33], s[1 * 33]); o.y = pk2(s[2 * 33], s[3 * 33]); o.z = pk2(s[4 * 33], s[5 * 33]); o.w = pk2(s[6 * 33], s[7 * 33]);
        *(u32x4*)(WT + (size_t)(n0 + n) * K + k0 + 8 * c) = o; }
    asm volatile("s_waitcnt lgkmcnt(0)" ::: "memory");
}
DI void phase_p0(LAS unsigned char* lds, const Ctx& c, int l) {
    int tid = threadIdx.x; asm volatile("" : "+v"(tid)); const int lane = tid & 63, wave = __builtin_amdgcn_readfirstlane(tid >> 6);
    LAS float* scr = (LAS float*)(lds + wave * 8704);
    const int gw = blockIdx.x * NWAVE + wave, NGW = gridDim.x * NWAVE;
    unsigned char* ws = c.ws;
    constexpr int I_IN = 16 * 88, I_UQ = 6 * 24, I_UKV = 4 * 32, I_OUT = 16 * 32, I_GU = 16 * 176, I_DN = 44 * 32, I_PG = 16 * 32, I_PLE = 4 * 32;
    constexpr int NIT = I_IN + I_UQ + I_UKV + I_OUT + I_GU + I_DN + I_PG + I_PLE;
    for (int it = gw; it < NIT; it += NGW) {
        int r = it; const float* W; int K, Nsrc, Ndst, kind; size_t wt; const float* ksc = nullptr; const float *lg = nullptr, *lb = nullptr; float *gw = nullptr, *bw = nullptr;
        float* gwl = (float*)(ws + WS_GW) + (size_t)l * GW_LAYER;
        if (r < I_IN) { W = c.w_in + (size_t)l * 1024 * NIN_SRC; K = 1024; Nsrc = NIN_SRC; Ndst = NIN; wt = W_IN; kind = 0; }
        else if ((r -= I_IN) < I_UQ) { W = c.w_uq + (size_t)l * 384 * 768; K = 384; Nsrc = 768; Ndst = 768; wt = W_UQ; kind = 1; ksc = c.qn_g + l * 384; }
        else if ((r -= I_UQ) < I_UKV) { W = c.w_ukv + (size_t)l * 256 * 1024; K = 256; Nsrc = 1024; Ndst = 1024; wt = W_UKV; kind = 3; ksc = c.kvn_g + l * 256; }
        else if ((r -= I_UKV) < I_OUT) { W = c.w_out + (size_t)l * 1024 * 1024; K = 1024; Nsrc = 1024; Ndst = 1024; wt = W_OUT; kind = 3; }
        else if ((r -= I_OUT) < I_GU) { W = c.w_gu + (size_t)l * 1024 * 5632; K = 1024; Nsrc = 5632; Ndst = 5632; wt = W_GU; kind = 2; lg = c.ln1_g + l * DM; lb = c.ln1_b + l * DM; gw = gwl; bw = gwl + 5632; }
        else if ((r -= I_GU) < I_DN) { W = c.w_dn + (size_t)l * 2816 * 1024; K = 2816; Nsrc = 1024; Ndst = 1024; wt = W_DN; kind = 3; }
        else if ((r -= I_DN) < I_PG) { W = c.w_pg + (size_t)l * 1024 * 1024; K = 1024; Nsrc = 1024; Ndst = 1024; wt = W_PG; kind = 3; lg = c.ln2_g + l * DM; lb = c.ln2_b + l * DM; gw = gwl + 2 * 5632; bw = gwl + 2 * 5632 + 1024; }
        else { r -= I_PG; W = c.w_ple + (size_t)l * 256 * 1024; K = 256; Nsrc = 1024; Ndst = 1024; wt = W_PLE; kind = 3; }
        transpose_item(W, K, Nsrc, Ndst, (bf16_t*)(ws + wt), scr, r, lane, ksc, kind, lg, lb, gw, bw);
    }
    const size_t gt = (size_t)blockIdx.x * NT + tid, GT = (size_t)gridDim.x * NT;
    {
        const f32x4* src = (const f32x4*)(c.p + (size_t)l * T * 256); u32x4* dst = (u32x4*)(ws + WS_PB);
        for (size_t i = gt; i < (size_t)T * 256 / 8; i += GT) dst[i] = pack8(src[2 * i], src[2 * i + 1]);
    }
    {
        f32x4* z = (f32x4*)(ws + WS_SSQ);
        for (size_t i = gt; i < (size_t)3 * T * 2 / 4; i += GT) z[i] = (f32x4){0.f, 0.f, 0.f, 0.f};
    }
    if (l == 0) {
        const f32x4* src = (const f32x4*)c.x; u32x4* dst = (u32x4*)(ws + WS_XB);
        for (size_t i = gt; i < (size_t)T * DM / 8; i += GT) dst[i] = pack8(src[2 * i], src[2 * i + 1]);
        float* ct = (float*)(ws + WS_COS); float* st = (float*)(ws + WS_SIN);
        for (size_t i = gt; i < (size_t)T * 32; i += GT) {
            const int t = (int)(i >> 5), j = (int)(i & 31);
            const float ang = (float)c.pos[t] * INV_FREQ[j];
            float sn, cs; sincos_f32(ang, sn, cs);
            ct[i] = cs; st[i] = sn;
        }
        if (blockIdx.x == 0 && tid < 64) ((unsigned*)(ws + WS_CTR))[tid] = 0u;
    }
}

typedef const f32x4 (&AccRef)[2][2][4][2];

struct EpiIn {
    static constexpr bool PERM = true, AFTER_DRAIN = false;
    unsigned char* ws;
    DI void operator()(AccRef acc, const Unit& u, int wr, int wc, int fr, int fq) const {
        unsigned char* w_ = ws; asm volatile("" : "+s"(w_));
        bf16_t *QKV = (bf16_t*)(w_ + WS_QKV), *Z = (bf16_t*)(w_ + WS_Z), *CQ = (bf16_t*)(w_ + WS_CQ), *CKV = (bf16_t*)(w_ + WS_CKV), *KR = (bf16_t*)(w_ + WS_KR); float *AB = (float*)(w_ + WS_AB), *SSQ = (float*)(w_ + WS_SSQ); const float *COS = (const float*)(w_ + WS_COS), *SIN = (const float*)(w_ + WS_SIN);
        const int pn = u.pn, row0 = u.pm * 256 + wr * 64 + fr, cl = wc * 32 + 8 * fq;
        if (pn < 8) {
            bf16_t* base; int ld, c0;
            if (pn < 6) { base = QKV; ld = 1536; c0 = pn * 256; } else { base = Z; ld = 512; c0 = (pn - 6) * 256; }
#pragma unroll
            for (int ai = 0; ai < 2; ++ai)
#pragma unroll
                for (int m = 0; m < 4; ++m) { int row_ = row0 + ai * 128 + m * 16; asm volatile("" : "+v"(row_) :: "memory"); bf16_t* rp = base + (size_t)row_ * ld + c0 + cl;
#pragma unroll
                    for (int bj = 0; bj < 2; ++bj) { f32x4 a = acc[ai][bj][m][0], b = acc[ai][bj][m][1];
                        if (pn >= 6) {
#pragma unroll
                            for (int i = 0; i < 4; ++i) { a[i] = siluf_(a[i]); b[i] = siluf_(b[i]); } }
                        *(u32x4*)(rp + bj * 128) = pack8(a, b); } }
        } else if (pn == 8 || pn == 10) {
            bf16_t* base = pn == 8 ? CQ : CKV; const int ld = pn == 8 ? 384 : 256, which = pn == 8 ? 0 : 1;
#pragma unroll
            for (int ai = 0; ai < 2; ++ai)
#pragma unroll
                for (int m = 0; m < 4; ++m) { int row = row0 + ai * 128 + m * 16; asm volatile("" : "+v"(row) :: "memory"); bf16_t* rp = base + (size_t)row * ld + cl; float ss = 0.f;
#pragma unroll
                    for (int bj = 0; bj < 2; ++bj) { const f32x4 a = acc[ai][bj][m][0], b = acc[ai][bj][m][1]; *(u32x4*)(rp + bj * 128) = pack8(a, b);
                        ss += (a[0] * a[0] + a[1] * a[1]) + (a[2] * a[2] + a[3] * a[3]) + (b[0] * b[0] + b[1] * b[1]) + (b[2] * b[2] + b[3] * b[3]); }
                    ss += __shfl_xor(ss, 16); ss += __shfl_xor(ss, 32);
                    if (fq == 0) unsafeAtomicAdd(SSQ + (size_t)row * 2 + which, ss); }
        } else {
#pragma unroll
            for (int ai = 0; ai < 2; ++ai)
#pragma unroll
                for (int m = 0; m < 4; ++m) { int row = row0 + ai * 128 + m * 16; asm volatile("" : "+v"(row) :: "memory");
                    { const f32x4 a = acc[ai][0][m][0], b = acc[ai][0][m][1]; *(u32x4*)(CQ + (size_t)row * 384 + 256 + cl) = pack8(a, b);
                      float ss = (a[0] * a[0] + a[1] * a[1]) + (a[2] * a[2] + a[3] * a[3]) + (b[0] * b[0] + b[1] * b[1]) + (b[2] * b[2] + b[3] * b[3]);
                      ss += __shfl_xor(ss, 16); ss += __shfl_xor(ss, 32);
                      if (fq == 0) unsafeAtomicAdd(SSQ + (size_t)row * 2, ss); }
                    if (wc < 2) {
                        const int i0 = 16 * wc + 4 * fq; const f32x4 cs = *(const f32x4*)(COS + (size_t)row * 32 + i0), sn = *(const f32x4*)(SIN + (size_t)row * 32 + i0);
                        const f32x4 a = acc[ai][1][m][0], b = acc[ai][1][m][1]; f32x4 oa, ob;
                        oa[0] = a[0] * cs[0] - a[1] * sn[0]; oa[1] = a[1] * cs[0] + a[0] * sn[0]; oa[2] = a[2] * cs[1] - a[3] * sn[1]; oa[3] = a[3] * cs[1] + a[2] * sn[1];
                        ob[0] = b[0] * cs[2] - b[1] * sn[2]; ob[1] = b[1] * cs[2] + b[0] * sn[2]; ob[2] = b[2] * cs[3] - b[3] * sn[3]; ob[3] = b[3] * cs[3] + b[2] * sn[3];
                        *(u32x4*)(KR + (size_t)row * 64 + cl) = pack8(oa, ob);
                    } else if (wc == 2 && fq == 0) {
                        *(f32x4*)(AB + (size_t)row * 8) = acc[ai][1][m][0]; *(f32x4*)(AB + (size_t)row * 8 + 4) = acc[ai][1][m][1];
                    }
                    asm volatile("" ::: "memory"); }
        }
    }
};

struct EpiQ {
    static constexpr bool PERM = true, AFTER_DRAIN = false;
    unsigned char* ws;
    DI void operator()(AccRef acc, const Unit& u, int wr, int wc, int fr, int fq) const {
        unsigned char* w_ = ws; asm volatile("" : "+s"(w_));
        bf16_t* QM = (bf16_t*)(w_ + WS_QM); const float *SSQ = (const float*)(w_ + WS_SSQ), *COS = (const float*)(w_ + WS_COS), *SIN = (const float*)(w_ + WS_SIN);
        const int row0 = u.pm * 256 + wr * 64 + fr, cl = wc * 32 + 8 * fq;
#pragma unroll
        for (int ai = 0; ai < 2; ++ai)
#pragma unroll
            for (int m = 0; m < 4; ++m) { int row = row0 + ai * 128 + m * 16; asm volatile("" : "+v"(row) :: "memory"); const int b = row >> 13, s = row & 8191;
                const float rs = __builtin_amdgcn_rsqf(SSQ[(size_t)row * 2] * (1.f / 384.f) + RMS_EPS) * QSCALE;
#pragma unroll
                for (int bj = 0; bj < 2; ++bj) { const int cg_ = u.pn * 256 + bj * 128 + cl, h = cg_ / 192, d = cg_ % 192;
                    f32x4 a = acc[ai][bj][m][0] * rs, bb = acc[ai][bj][m][1] * rs;
                    if (d >= 128) { const int i0 = (d - 128) >> 1; const f32x4 cs = *(const f32x4*)(COS + (size_t)row * 32 + i0), sn = *(const f32x4*)(SIN + (size_t)row * 32 + i0); f32x4 oa, ob;
                        oa[0] = a[0] * cs[0] - a[1] * sn[0]; oa[1] = a[1] * cs[0] + a[0] * sn[0]; oa[2] = a[2] * cs[1] - a[3] * sn[1]; oa[3] = a[3] * cs[1] + a[2] * sn[1];
                        ob[0] = bb[0] * cs[2] - bb[1] * sn[2]; ob[1] = bb[1] * cs[2] + bb[0] * sn[2]; ob[2] = bb[2] * cs[3] - bb[3] * sn[3]; ob[3] = bb[3] * cs[3] + bb[2] * sn[3];
                        a = oa; bb = ob; }
                    *(u32x4*)(QM + ((size_t)(b * 4 + h) * SEQ + s) * 192 + d) = pack8(a, bb); asm volatile("" ::: "memory"); } }
    }
};

struct EpiKV {
    static constexpr bool PERM = true, AFTER_DRAIN = false;
    unsigned char* ws;
    DI void operator()(AccRef acc, const Unit& u, int wr, int wc, int fr, int fq) const {
        unsigned char* w_ = ws; asm volatile("" : "+s"(w_));
        bf16_t *KN = (bf16_t*)(w_ + WS_KN), *VT = (bf16_t*)(w_ + WS_VT); const float* SSQ = (const float*)(w_ + WS_SSQ);
        const int row0 = u.pm * 256 + wr * 64 + fr, cl = wc * 32 + 8 * fq, h = u.pn;
#pragma unroll
        for (int ai = 0; ai < 2; ++ai)
#pragma unroll
            for (int m = 0; m < 4; ++m) { int row = row0 + ai * 128 + m * 16; asm volatile("" : "+v"(row) :: "memory"); const int b = row >> 13, s = row & 8191;
                const float rs = __builtin_amdgcn_rsqf(SSQ[(size_t)row * 2 + 1] * (1.f / 256.f) + RMS_EPS);
                *(u32x4*)(KN + ((size_t)(b * 4 + h) * SEQ + s) * 128 + cl) = pack8(acc[ai][0][m][0] * rs, acc[ai][0][m][1] * rs);
                bf16_t* vp = VT + ((size_t)(b * 4 + h) * 128 + cl) * SEQ + s;
#pragma unroll
                for (int n = 0; n < 2; ++n)
#pragma unroll
                    for (int i = 0; i < 4; ++i) { *vp = (bf16_t)(pk2(acc[ai][1][m][n][i] * rs, 0.f) & 0xffffu); vp += SEQ; asm volatile("" : "+v"(vp)); } }
    }
};

DI f32x2 ln_stats(const float* ST, int row) {
    const f32x2 a = *(const f32x2*)(ST + (size_t)row * 2); const float mean = a.x * (1.f / DM); const float var = fmaxf(a.y * (1.f / DM) - mean * mean, 0.f);
    return (f32x2){mean, __builtin_amdgcn_rsqf(var + LN_EPS)};
}
struct EpiOut {
    static constexpr bool PERM = true, AFTER_DRAIN = false;
    const float* X; unsigned char* ws; const float* G;
    DI void operator()(AccRef acc, const Unit& u, int wr, int wc, int fr, int fq) const {
        unsigned char* w_ = ws; asm volatile("" : "+s"(w_)); float* Y = (float*)(w_ + WS_Y); bf16_t* YG = (bf16_t*)(w_ + WS_X1B); float* ST = (float*)(w_ + WS_ST1);
        const int row0 = u.pm * 256 + wr * 64 + fr, c0 = u.pn * 256 + wc * 32 + 8 * fq;
        f32x4 xb[2][2][2];
        { int r0_ = row0; asm volatile("" : "+v"(r0_) :: "memory"); const size_t o0 = (size_t)r0_ * DM + c0;
#pragma unroll
          for (int bj = 0; bj < 2; ++bj)
#pragma unroll
            for (int n = 0; n < 2; ++n) xb[0][bj][n] = *(const f32x4*)(X + o0 + bj * 128 + 4 * n); }
#pragma unroll
        for (int it = 0; it < 8; ++it) { const int ai = it >> 2, m = it & 3, cur = it & 1;
            if (it + 1 < 8) { int rn_ = row0 + ((it + 1) >> 2) * 128 + ((it + 1) & 3) * 16; asm volatile("" : "+v"(rn_) :: "memory"); const size_t on = (size_t)rn_ * DM + c0;
#pragma unroll
                for (int bj = 0; bj < 2; ++bj)
#pragma unroll
                    for (int n = 0; n < 2; ++n) xb[cur ^ 1][bj][n] = *(const f32x4*)(X + on + bj * 128 + 4 * n); }
            int row_ = row0 + ai * 128 + m * 16; asm volatile("" : "+v"(row_)); const size_t off = (size_t)row_ * DM + c0; float s1 = 0.f, s2 = 0.f;
#pragma unroll
            for (int bj = 0; bj < 2; ++bj) { f32x4 y[2];
#pragma unroll
                for (int n = 0; n < 2; ++n) { y[n] = xb[cur][bj][n] * ALPHA + acc[ai][bj][m][n]; *(f32x4*)(Y + off + bj * 128 + 4 * n) = y[n];
                    s1 += (y[n][0] + y[n][1]) + (y[n][2] + y[n][3]); s2 += (y[n][0] * y[n][0] + y[n][1] * y[n][1]) + (y[n][2] * y[n][2] + y[n][3] * y[n][3]); }
                const f32x4 g0 = *(const f32x4*)(G + c0 + bj * 128), g1 = *(const f32x4*)(G + c0 + bj * 128 + 4);
                *(u32x4*)(YG + off + bj * 128) = pack8(y[0] * g0, y[1] * g1); }
            s1 += __shfl_xor(s1, 16); s1 += __shfl_xor(s1, 32); s2 += __shfl_xor(s2, 16); s2 += __shfl_xor(s2, 32);
            if (fq == 0) { unsafeAtomicAdd(ST + (size_t)row_ * 2, s1); unsafeAtomicAdd(ST + (size_t)row_ * 2 + 1, s2); } }
    }
};

struct EpiSwiGLU {
    static constexpr bool PERM = true, AFTER_DRAIN = false;
    unsigned char* ws; const float* GW;
    DI void operator()(AccRef acc, const Unit& u, int wr, int wc, int fr, int fq) const {
        unsigned char* w_ = ws; asm volatile("" : "+s"(w_)); bf16_t* HID = (bf16_t*)(w_ + WS_HID); const float* ST = (const float*)(w_ + WS_ST1);
        const int row0 = u.pm * 256 + wr * 64 + fr, c0 = u.pn * 128 + wc * 32 + 8 * fq, wrow = u.pn * 256 + wc * 32 + 8 * fq;
        f32x4 gwv[2][2], bwv[2][2];
#pragma unroll
        for (int bj = 0; bj < 2; ++bj)
#pragma unroll
            for (int n = 0; n < 2; ++n) { gwv[bj][n] = *(const f32x4*)(GW + wrow + bj * 128 + 4 * n); bwv[bj][n] = *(const f32x4*)(GW + 5632 + wrow + bj * 128 + 4 * n); }
        f32x2 sta[8];
#pragma unroll
        for (int it = 0; it < 8; ++it) sta[it] = *(const f32x2*)(ST + (size_t)(row0 + (it >> 2) * 128 + (it & 3) * 16) * 2);
#pragma unroll
        for (int ai = 0; ai < 2; ++ai)
#pragma unroll
            for (int m = 0; m < 4; ++m) { int row_ = row0 + ai * 128 + m * 16; asm volatile("" : "+v"(row_) :: "memory");
                const float mean_ = sta[ai * 4 + m].x * (1.f / DM); const f32x2 st = {mean_, __builtin_amdgcn_rsqf(fmaxf(sta[ai * 4 + m].y * (1.f / DM) - mean_ * mean_, 0.f) + LN_EPS)}; f32x4 o[2];
#pragma unroll
                for (int n = 0; n < 2; ++n) { const f32x4 gt = (acc[ai][0][m][n] - gwv[0][n] * st.x) * st.y + bwv[0][n], up = (acc[ai][1][m][n] - gwv[1][n] * st.x) * st.y + bwv[1][n];
#pragma unroll
                    for (int i = 0; i < 4; ++i) o[n][i] = siluf_(gt[i]) * up[i]; }
                *(u32x4*)(HID + (size_t)row_ * DFF + c0) = pack8(o[0], o[1]); }
    }
};

struct EpiDown {
    static constexpr bool PERM = true, AFTER_DRAIN = false;
    unsigned char* ws; const float *G, *Bv, *G2;
    DI void operator()(AccRef acc, const Unit& u, int wr, int wc, int fr, int fq) const {
        unsigned char* w_ = ws; asm volatile("" : "+s"(w_)); float* Y = (float*)(w_ + WS_Y); bf16_t* YG = (bf16_t*)(w_ + WS_X1B); const float* ST = (const float*)(w_ + WS_ST1); float* ST2 = (float*)(w_ + WS_ST2);
        const int row0 = u.pm * 256 + wr * 64 + fr, c0 = u.pn * 256 + wc * 32 + 8 * fq;
        f32x4 yb[2][2][2]; f32x2 sb[2];
        { int r0_ = row0; asm volatile("" : "+v"(r0_) :: "memory"); const size_t o0 = (size_t)r0_ * DM + c0; sb[0] = *(const f32x2*)(ST + (size_t)r0_ * 2);
#pragma unroll
          for (int bj = 0; bj < 2; ++bj)
#pragma unroll
            for (int n = 0; n < 2; ++n) yb[0][bj][n] = *(const f32x4*)(Y + o0 + bj * 128 + 4 * n); }
#pragma unroll
        for (int it = 0; it < 8; ++it) { const int ai = it >> 2, m = it & 3, cur = it & 1;
            if (it + 1 < 8) { int rn_ = row0 + ((it + 1) >> 2) * 128 + ((it + 1) & 3) * 16; asm volatile("" : "+v"(rn_) :: "memory"); const size_t on = (size_t)rn_ * DM + c0; sb[cur ^ 1] = *(const f32x2*)(ST + (size_t)rn_ * 2);
#pragma unroll
                for (int bj = 0; bj < 2; ++bj)
#pragma unroll
                    for (int n = 0; n < 2; ++n) yb[cur ^ 1][bj][n] = *(const f32x4*)(Y + on + bj * 128 + 4 * n); }
            int row = row0 + ai * 128 + m * 16; asm volatile("" : "+v"(row)); const size_t off = (size_t)row * DM + c0; float s1 = 0.f, s2 = 0.f;
            const float mean = sb[cur].x * (1.f / DM); const float rstd = __builtin_amdgcn_rsqf(fmaxf(sb[cur].y * (1.f / DM) - mean * mean, 0.f) + LN_EPS);
#pragma unroll
            for (int bj = 0; bj < 2; ++bj) { f32x4 y[2];
#pragma unroll
                for (int n = 0; n < 2; ++n) { const int cc = c0 + bj * 128 + 4 * n; const f32x4 gv = *(const f32x4*)(G + cc), bv = *(const f32x4*)(Bv + cc);
                    const f32x4 x1 = (yb[cur][bj][n] - mean) * rstd * gv + bv;
                    y[n] = x1 * ALPHA + acc[ai][bj][m][n]; *(f32x4*)(Y + off + bj * 128 + 4 * n) = y[n];
                    s1 += (y[n][0] + y[n][1]) + (y[n][2] + y[n][3]); s2 += (y[n][0] * y[n][0] + y[n][1] * y[n][1]) + (y[n][2] * y[n][2] + y[n][3] * y[n][3]); }
                const f32x4 g0 = *(const f32x4*)(G2 + c0 + bj * 128), g1 = *(const f32x4*)(G2 + c0 + bj * 128 + 4);
                *(u32x4*)(YG + off + bj * 128) = pack8(y[0] * g0, y[1] * g1); }
            s1 += __shfl_xor(s1, 16); s1 += __shfl_xor(s1, 32); s2 += __shfl_xor(s2, 16); s2 += __shfl_xor(s2, 32);
            if (fq == 0) { unsafeAtomicAdd(ST2 + (size_t)row * 2, s1); unsafeAtomicAdd(ST2 + (size_t)row * 2 + 1, s2); } }
    }
};

struct EpiE {
    static constexpr bool PERM = true, AFTER_DRAIN = false;
    unsigned char* ws;
    DI void operator()(AccRef acc, const Unit& u, int wr, int wc, int fr, int fq) const {
        unsigned char* w_ = ws; asm volatile("" : "+s"(w_)); bf16_t* E = (bf16_t*)(w_ + WS_E);
        const int row0 = u.pm * 256 + wr * 64 + fr, c0 = u.pn * 256 + wc * 32 + 8 * fq;
#pragma unroll
        for (int ai = 0; ai < 2; ++ai)
#pragma unroll
            for (int m = 0; m < 4; ++m) { int row_ = row0 + ai * 128 + m * 16; asm volatile("" : "+v"(row_) :: "memory"); const size_t off = (size_t)row_ * DM + c0;
#pragma unroll
                for (int bj = 0; bj < 2; ++bj) *(u32x4*)(E + off + bj * 128) = pack8(acc[ai][bj][m][0], acc[ai][bj][m][1]); }
    }
};

struct EpiPle {
    static constexpr bool PERM = true, AFTER_DRAIN = false;
    unsigned char* ws; const float *G, *Bv; float* OUT; const float* GW;
    DI void operator()(AccRef acc, const Unit& u, int wr, int wc, int fr, int fq) const {
        unsigned char* w_ = ws; asm volatile("" : "+s"(w_)); const float *Y = (const float*)(w_ + WS_Y), *ST = (const float*)(w_ + WS_ST2); const bf16_t* E = (const bf16_t*)(w_ + WS_E); bf16_t* XB = (bf16_t*)(w_ + WS_XB);
        const int row0 = u.pm * 256 + wr * 64 + fr, c0 = u.pn * 256 + wc * 32 + 8 * fq;
        f32x4 yb[2][2][2]; u32x4 eb[2][2]; f32x2 sb[2];
        { int r0_ = row0; asm volatile("" : "+v"(r0_) :: "memory"); const size_t o0 = (size_t)r0_ * DM + c0; sb[0] = *(const f32x2*)(ST + (size_t)r0_ * 2);
#pragma unroll
          for (int bj = 0; bj < 2; ++bj) { eb[0][bj] = *(const u32x4*)(E + o0 + bj * 128);
#pragma unroll
            for (int n = 0; n < 2; ++n) yb[0][bj][n] = *(const f32x4*)(Y + o0 + bj * 128 + 4 * n); } }
#pragma unroll
        for (int it = 0; it < 8; ++it) { const int ai = it >> 2, m = it & 3, cur = it & 1;
            if (it + 1 < 8) { int rn_ = row0 + ((it + 1) >> 2) * 128 + ((it + 1) & 3) * 16; asm volatile("" : "+v"(rn_) :: "memory"); const size_t on = (size_t)rn_ * DM + c0; sb[cur ^ 1] = *(const f32x2*)(ST + (size_t)rn_ * 2);
#pragma unroll
                for (int bj = 0; bj < 2; ++bj) { eb[cur ^ 1][bj] = *(const u32x4*)(E + on + bj * 128);
#pragma unroll
                    for (int n = 0; n < 2; ++n) yb[cur ^ 1][bj][n] = *(const f32x4*)(Y + on + bj * 128 + 4 * n); } }
            int row = row0 + ai * 128 + m * 16; asm volatile("" : "+v"(row)); const size_t off = (size_t)row * DM + c0;
            const float mean = sb[cur].x * (1.f / DM); const float rstd = __builtin_amdgcn_rsqf(fmaxf(sb[cur].y * (1.f / DM) - mean * mean, 0.f) + LN_EPS);
#pragma unroll
            for (int bj = 0; bj < 2; ++bj)
#pragma unroll
                for (int n = 0; n < 2; ++n) { const int cc = c0 + bj * 128 + 4 * n; const f32x4 gv = *(const f32x4*)(G + cc), bv = *(const f32x4*)(Bv + cc), gw = *(const f32x4*)(GW + cc), bw = *(const f32x4*)(GW + 1024 + cc);
                    const unsigned e0 = eb[cur][bj][2 * n], e1 = eb[cur][bj][2 * n + 1]; const f32x4 ev = {lo_bf(e0), hi_bf(e0), lo_bf(e1), hi_bf(e1)};
                    const f32x4 x2 = (yb[cur][bj][n] - mean) * rstd * gv + bv; const f32x4 a = (acc[ai][bj][m][n] - gw * mean) * rstd + bw; f32x4 o;
#pragma unroll
                    for (int i = 0; i < 4; ++i) o[i] = x2[i] + sigmoidf_(a[i]) * ev[i];
                    *(f32x4*)(OUT + off + bj * 128 + 4 * n) = o; u32x2 w2; w2.x = pk2(o[0], o[1]); w2.y = pk2(o[2], o[3]);
                    *(u32x2*)(XB + off + bj * 128 + 4 * n) = w2; } }
    }
};

template <class Epi> DI void run_gemm(LAS unsigned char* lds, const bf16_t* A, const bf16_t* Bt, int M, int N, int K, const Epi& E) {
    asm volatile("" : "+s"(K));
    pg8::Gemm g{A, Bt, M, N, K}; pg8::StaticOrder S; S.init(M, N, (int)gridDim.x, (int)blockIdx.x);
    pg8::gemm_phase<Epi, pg8::StaticOrder, true, true>(lds, g, S, E);
    __syncthreads();
}

DI void phase_ln(const float* Y, const float* G, const float* Bv, bf16_t* XN, float* ST) {
    int tid = threadIdx.x; asm volatile("" : "+v"(tid)); const int lane = tid & 63, wave = __builtin_amdgcn_readfirstlane(tid >> 6);
    const int gw = blockIdx.x * NWAVE + wave, NGW = gridDim.x * NWAVE;
    f32x4 gv[4], bv[4];
#pragma unroll
    for (int j = 0; j < 4; ++j) { gv[j] = *(const f32x4*)(G + 4 * lane + 256 * j); bv[j] = *(const f32x4*)(Bv + 4 * lane + 256 * j); }
    for (int row = gw; row < T; row += NGW) {
        const f32x4* yr = (const f32x4*)(Y + (size_t)row * DM) + lane; f32x4 v[4]; float s = 0.f;
#pragma unroll
        for (int j = 0; j < 4; ++j) { v[j] = yr[64 * j]; s += (v[j][0] + v[j][1]) + (v[j][2] + v[j][3]); }
        const float mean = wave_sum(s) * (1.f / DM); float s2 = 0.f;
#pragma unroll
        for (int j = 0; j < 4; ++j) { v[j] = v[j] - mean; s2 += (v[j][0] * v[j][0] + v[j][1] * v[j][1]) + (v[j][2] * v[j][2] + v[j][3] * v[j][3]); }
        const float rstd = __builtin_amdgcn_rsqf(wave_sum(s2) * (1.f / DM) + LN_EPS);
        u32x2* o8 = (u32x2*)(XN + (size_t)row * DM) + lane;
#pragma unroll
        for (int j = 0; j < 4; ++j) { const f32x4 o = v[j] * rstd * gv[j] + bv[j]; u32x2 w; w.x = pk2(o[0], o[1]); w.y = pk2(o[2], o[3]); o8[64 * j] = w; }
        if (lane == 0) *(f32x2*)(ST + (size_t)row * 2) = (f32x2){mean, rstd};
    }
}

constexpr int GP_QB = 0, GP_KB = 17408, GP_KF = 34816, GP_VF = 67840, GP_LM = 100864, GP_BETA = 117248, GP_G = 117504, GP_EG = 117760, GP_BEK = 118016;
DI bf16x8 lds_frag16(const LAS unsigned char* p) { return *(const LAS bf16x8*)p; }
DI void gdn_prep_item(LAS unsigned char* lds, const Ctx& c, int l, int item) {
    int tid = threadIdx.x; asm volatile("" : "+v"(tid)); const int lane = tid & 63, wave = __builtin_amdgcn_readfirstlane(tid >> 6);
    const int h = item & 3, n = (item >> 2) & 127, b = item >> 9;
    const int tok0 = b * SEQ + n * 64;
    const size_t cidx = (size_t)(b * 4 + h) * 128 + n;
    unsigned char* ws = c.ws;
    const bf16_t* QKV = (const bf16_t*)(ws + WS_QKV); const float* AB = (const float*)(ws + WS_AB);
    LAS float* betaL = (LAS float*)(lds + GP_BETA); LAS float* gL = (LAS float*)(lds + GP_G); LAS float* egL = (LAS float*)(lds + GP_EG);
    LAS float* kf = (LAS float*)(lds + GP_KF); LAS float* vf = (LAS float*)(lds + GP_VF); LAS float* Lm = (LAS float*)(lds + GP_LM);
    if (wave == 0) {
        const float bl = AB[(size_t)(tok0 + lane) * 8 + h], al = AB[(size_t)(tok0 + lane) * 8 + 4 + h];
        const float beta = sigmoidf_(bl);
        const float xx = al + c.dt_bias[l * 4 + h];
        const float e_ = __expf(-fabsf(xx));
        const float l1p = e_ < 0.01f ? e_ * (1.f - e_ * (0.5f - e_ * (1.f / 3.f))) : __logf(1.f + e_);
        const float sp = fmaxf(xx, 0.f) + l1p;
        float gv = -__expf(c.a_log[l * 4 + h]) * sp;
#pragma unroll
        for (int o = 1; o < 64; o <<= 1) { const float t = __shfl_up(gv, o); if (lane >= o) gv += t; }
        betaL[lane] = beta; gL[lane] = gv; const float eg_ = __expf(gv); egL[lane] = eg_; ((LAS float*)(lds + GP_BEK))[lane] = beta * eg_;
    }
    {
        const int cp = lane, tg = wave;
        unsigned xin[3][11]; f32x2 cwv[3][4];
#pragma unroll
        for (int which = 0; which < 3; ++which) {
            const int cb = which * 512 + h * 128 + 2 * cp;
#pragma unroll
            for (int r = 0; r < 11; ++r) { const int sl = n * 64 + 8 * tg - 3 + r; xin[which][r] = sl >= 0 ? *(const unsigned*)(QKV + (size_t)(b * SEQ + sl) * 1536 + cb) : 0u; }
#pragma unroll
            for (int j = 0; j < 4; ++j) cwv[which][j] = *(const f32x2*)(c.conv_w + (size_t)l * 4 * 1536 + cb + j * 1536);
        }
#pragma unroll
        for (int which = 0; which < 3; ++which) {
            float w0[4], w1[4];
#pragma unroll
            for (int j = 0; j < 4; ++j) { w0[j] = cwv[which][j].x; w1[j] = cwv[which][j].y; }
            float x0[11], x1[11];
#pragma unroll
            for (int r = 0; r < 11; ++r) { x0[r] = lo_bf(xin[which][r]); x1[r] = hi_bf(xin[which][r]); }
#pragma unroll
            for (int t = 0; t < 8; ++t) {
                float a0 = 0.f, a1 = 0.f;
#pragma unroll
                for (int j = 0; j < 4; ++j) { a0 += w0[j] * x0[t + j]; a1 += w1[j] * x1[t + j]; }
                a0 = siluf_(a0); a1 = siluf_(a1);
                const int tl = 8 * tg + t;
                if (which < 2) {
                    const float ss = wave_sum(a0 * a0 + a1 * a1); float rs = __builtin_amdgcn_rsqf(ss + RMS_EPS); if (which == 0) rs *= 0.08838834764831845f;
                    a0 *= rs; a1 *= rs;
                    *(LAS unsigned*)(lds + (which == 0 ? GP_QB : GP_KB) + tl * 272 + cp * 4) = pk2(a0, a1);
                    if (which == 1) { kf[tl * 129 + 2 * cp] = a0; kf[tl * 129 + 2 * cp + 1] = a1; }
                } else { vf[tl * 129 + 2 * cp] = a0; vf[tl * 129 + 2 * cp + 1] = a1; }
            }
        }
    }
    BLOCK_SYNC();
    {
        const int mat = wave >> 2, rb = wave & 3, m16 = lane & 15, g4 = lane >> 4;
        const LAS unsigned char* Ab = lds + (mat == 0 ? GP_KB : GP_QB) + (16 * rb + m16) * 272 + g4 * 16;
        bf16x8 af[4];
#pragma unroll
        for (int ks = 0; ks < 4; ++ks) af[ks] = lds_frag16(Ab + ks * 64);
        bf16_t* ATg = (bf16_t*)(ws + WS_AT) + cidx * 4096;
        for (int cb = 0; cb <= rb; ++cb) {
            f32x4 d = {0.f, 0.f, 0.f, 0.f};
            const LAS unsigned char* Bb = lds + GP_KB + (16 * cb + m16) * 272 + g4 * 16;
#pragma unroll
            for (int ks = 0; ks < 4; ++ks) d = __builtin_amdgcn_mfma_f32_16x16x32_bf16(af[ks], lds_frag16(Bb + ks * 64), d, 0, 0, 0);
            const int j = 16 * cb + m16; const float gj = gL[j];
            f32x4 lv;
#pragma unroll
            for (int r = 0; r < 4; ++r) { const int i = 16 * rb + 4 * g4 + r; const float dec = __expf(gL[i] - gj);
                if (mat == 0) lv[r] = (j < i) ? betaL[i] * d[r] * dec : 0.f;
                else ATg[i * 64 + j] = (bf16_t)(pk2((j <= i) ? d[r] * dec : 0.f, 0.f) & 0xffffu); }
            if (mat == 0) *(LAS f32x4*)(Lm + j * 64 + 16 * rb + 4 * g4) = lv;
        }
        if (mat == 1) for (int cb = rb + 1; cb < 4; ++cb) {
#pragma unroll
            for (int r = 0; r < 4; ++r) ATg[(16 * rb + 4 * g4 + r) * 64 + 16 * cb + m16] = 0; }
    }
    BLOCK_SYNC();
    if (tid < 256) {
        const int col = tid; const LAS float* src = col < 128 ? vf + col : kf + (col - 128); const LAS float* mul = col < 128 ? betaL : (LAS float*)(lds + GP_BEK);
        const LAS float* Lb = Lm; asm volatile("" : "+v"(Lb)); asm volatile("" : "+v"(mul));
        float xr[64];
#pragma unroll
        for (int i = 0; i < 64; ++i) xr[i] = src[i * 129] * mul[i];
#pragma unroll
        for (int j = 0; j < 63; ++j) {
            const float xj = xr[j];
#pragma unroll
            for (int i4 = (j + 1) / 4; i4 < 16; ++i4) { const f32x4 Lv = *(const LAS f32x4*)(Lb + j * 64 + 4 * i4);
#pragma unroll
                for (int q = 0; q < 4; ++q) xr[4 * i4 + q] -= Lv[q] * xj; }
#define PIN16(o) asm volatile("" : "+v"(xr[o]), "+v"(xr[o + 1]), "+v"(xr[o + 2]), "+v"(xr[o + 3]), "+v"(xr[o + 4]), "+v"(xr[o + 5]), "+v"(xr[o + 6]), "+v"(xr[o + 7]), "+v"(xr[o + 8]), "+v"(xr[o + 9]), "+v"(xr[o + 10]), "+v"(xr[o + 11]), "+v"(xr[o + 12]), "+v"(xr[o + 13]), "+v"(xr[o + 14]), "+v"(xr[o + 15]) :: "memory")
            PIN16(0); PIN16(16); PIN16(32); PIN16(48);
        }
        if (col < 128) {
            bf16_t* U = (bf16_t*)(ws + WS_UC) + cidx * 8192; const int cw = col >> 5, nn = col & 31;
#pragma unroll
            for (int mt = 0; mt < 2; ++mt)
#pragma unroll
                for (int j = 0; j < 4; ++j)
#pragma unroll
                    for (int g = 0; g < 2; ++g) { const int t0 = 32 * mt + 8 * j + 4 * g; u32x2 v; v.x = pk2(xr[t0], xr[t0 + 1]); v.y = pk2(xr[t0 + 2], xr[t0 + 3]);
                        *(u32x2*)(U + ((cw * 64 + 32 * g + nn) * 32 + 16 * mt + 4 * j)) = v; }
        } else {
            bf16_t* Wg = (bf16_t*)(ws + WS_WC) + cidx * 8192 + (col - 128);
#pragma unroll
            for (int i = 0; i < 64; ++i) Wg[i * 128] = (bf16_t)(pk2(xr[i], 0.f) & 0xffffu);
        }
    } else {
        const int t2 = tid - 256, l2 = t2 & 63, w2 = t2 >> 6;
        bf16_t* QDg = (bf16_t*)(ws + WS_QD) + cidx * 8192; bf16_t* KDg = (bf16_t*)(ws + WS_KDT) + cidx * 8192;
        const float glast = gL[63];
        for (int i = w2 * 16; i < w2 * 16 + 16; ++i) { const unsigned v = *(const LAS unsigned*)(lds + GP_QB + i * 272 + l2 * 4); const float e = egL[i];
            *(unsigned*)(QDg + i * 128 + 2 * l2) = pk2(lo_bf(v) * e, hi_bf(v) * e); }
        const float ek = __expf(glast - gL[l2]);
        for (int d = w2 * 32; d < w2 * 32 + 32; ++d) KDg[d * 64 + l2] = (bf16_t)(pk2(kf[l2 * 129 + d] * ek, 0.f) & 0xffffu);
        if (t2 == 0) ((float*)(ws + WS_GL))[cidx] = __expf(glast);
    }
    BLOCK_SYNC();
}

constexpr int SC_W = 0, SC_WSZ = 64 * 264, SC_Q = SC_WSZ, SC_K = 2 * SC_WSZ, SC_A = SC_K + 128 * 136, SC_BUF = SC_A + 64 * 136, SC_O = 2 * SC_BUF, SC_OSZ = 64 * 272;
DI bf16x8 lds_frag8x2(const LAS unsigned char* p) {
    const s16x4 a = *(const LAS s16x4*)p, b = *(const LAS s16x4*)(p + 32);
    return __builtin_shufflevector(a, b, 0, 1, 2, 3, 4, 5, 6, 7);
}
DI bf16x8 lds_frag32(const LAS unsigned char* p) {
    const s16x4 a = *(const LAS s16x4*)p, b = *(const LAS s16x4*)(p + 16);
    return __builtin_shufflevector(a, b, 0, 1, 2, 3, 4, 5, 6, 7);
}
DI bf16x8 pack_b(f32x4 a, f32x4 b) { return __builtin_bit_cast(bf16x8, pack8(a, b)); }
DI bf16x8 pack_h(const f32x16& x, int h8) {
    u32x4 w; w.x = pk2(x[8 * h8 + 0], x[8 * h8 + 1]); w.y = pk2(x[8 * h8 + 2], x[8 * h8 + 3]); w.z = pk2(x[8 * h8 + 4], x[8 * h8 + 5]); w.w = pk2(x[8 * h8 + 6], x[8 * h8 + 7]);
    return __builtin_bit_cast(bf16x8, w);
}
#define SC_RAW_BARRIER() do { asm volatile("s_waitcnt lgkmcnt(0)" ::: "memory"); __builtin_amdgcn_s_barrier(); asm volatile("" ::: "memory"); } while (0)
struct ScanH {
    const bf16_t *WC, *QD, *KD, *AT, *Zg; bf16_t* MIX; LAS unsigned char* lds; int b, h, ht, pt, pseg;
};
DI void sh_load(const ScanH& k, int nc, u32x4 (&st)[14]) {
    const size_t o8 = (size_t)nc * 8192; const int ht = k.ht;
#pragma unroll
    for (int i = 0; i < 4; ++i) { const int id = ht + 256 * i, r = id >> 4, cc = id & 15; st[i] = *(const u32x4*)(k.WC + o8 + r * 128 + cc * 8); st[4 + i] = *(const u32x4*)(k.QD + o8 + r * 128 + cc * 8); }
#pragma unroll
    for (int i = 0; i < 4; ++i) { const int id = ht + 256 * i, r = id >> 3, cc = id & 7; st[8 + i] = *(const u32x4*)(k.KD + o8 + r * 64 + cc * 8); }
#pragma unroll
    for (int i = 0; i < 2; ++i) { const int id = ht + 256 * i, r = id >> 3, cc = id & 7; st[12 + i] = *(const u32x4*)(k.AT + (size_t)nc * 4096 + r * 64 + cc * 8); }
}
DI void sh_store(const ScanH& k, int bf, const u32x4 (&st)[14]) {
    LAS unsigned char* B_ = k.lds + bf * SC_BUF; const int ht = k.ht;
#pragma unroll
    for (int i = 0; i < 4; ++i) { const int id = ht + 256 * i, r = id >> 4, cc = id & 15;
        *(LAS u32x2*)(B_ + SC_W + r * 264 + cc * 16) = (u32x2){st[i].x, st[i].y}; *(LAS u32x2*)(B_ + SC_W + r * 264 + cc * 16 + 8) = (u32x2){st[i].z, st[i].w};
        *(LAS u32x2*)(B_ + SC_Q + r * 264 + cc * 16) = (u32x2){st[4 + i].x, st[4 + i].y}; *(LAS u32x2*)(B_ + SC_Q + r * 264 + cc * 16 + 8) = (u32x2){st[4 + i].z, st[4 + i].w}; }
#pragma unroll
    for (int i = 0; i < 4; ++i) { const int id = ht + 256 * i, r = id >> 3, cc = id & 7;
        *(LAS u32x2*)(B_ + SC_K + r * 136 + cc * 16) = (u32x2){st[8 + i].x, st[8 + i].y}; *(LAS u32x2*)(B_ + SC_K + r * 136 + cc * 16 + 8) = (u32x2){st[8 + i].z, st[8 + i].w}; }
#pragma unroll
    for (int i = 0; i < 2; ++i) { const int id = ht + 256 * i, r = id >> 3, cc = id & 7;
        *(LAS u32x2*)(B_ + SC_A + r * 136 + cc * 16) = (u32x2){st[12 + i].x, st[12 + i].y}; *(LAS u32x2*)(B_ + SC_A + r * 136 + cc * 16 + 8) = (u32x2){st[12 + i].z, st[12 + i].w}; }
}
DI void scan_helper_step(const ScanH& k, int n, u32x4 (&stL)[14], const u32x4 (&stS)[14]) {
    LAS unsigned char* lds = k.lds; const int bf = n & 1, tokb = k.b * SEQ + n * 64;
    u32x4 zz[4];
    { const bf16_t* zp = k.Zg + (size_t)(tokb + k.pt) * 512 + k.h * 128 + 32 * k.pseg;
#pragma unroll
      for (int i = 0; i < 4; ++i) zz[i] = *(const u32x4*)(zp + 8 * i); }
    sh_load(k, n + 2 < 128 ? n + 2 : 127, stL);
    sh_store(k, bf ^ 1, stS);
    SC_RAW_BARRIER();
    const LAS unsigned char* ob = lds + SC_O + bf * SC_OSZ + k.pt * 272 + k.pseg * 64;
    const LAS float* gmL = (const LAS float*)(lds + SC_O + 2 * SC_OSZ + 512) + 32 * k.pseg;
    u32x4 ov4[4];
#pragma unroll
    for (int i = 0; i < 4; ++i) ov4[i] = *(const LAS u32x4*)(ob + 16 * i);
    float ss = 0.f;
#pragma unroll
    for (int i = 0; i < 4; ++i)
#pragma unroll
        for (int j = 0; j < 4; ++j) { const float a = lo_bf(ov4[i][j]), b2 = hi_bf(ov4[i][j]); ss += a * a + b2 * b2; }
    ss += __shfl_xor(ss, 1); ss += __shfl_xor(ss, 2);
    const float rs = __builtin_amdgcn_rsqf(ss * (1.f / 128.f) + RMS_EPS);
    bf16_t* mp = k.MIX + (size_t)(tokb + k.pt) * DM + k.h * 128 + 32 * k.pseg;
#pragma unroll
    for (int i = 0; i < 4; ++i) { u32x4 res;
#pragma unroll
        for (int j = 0; j < 4; ++j) { const int e = 8 * i + 2 * j;
            const float a0 = lo_bf(ov4[i][j]) * rs * gmL[e] * lo_bf(zz[i][j]), a1 = hi_bf(ov4[i][j]) * rs * gmL[e + 1] * hi_bf(zz[i][j]); res[j] = pk2(a0, a1); }
        *(u32x4*)(mp + 8 * i) = res; }
}
DI void scan_compute_step(LAS unsigned char* lds, int n, int cw, int lane, const bf16_t* UCl, f32x16 (&S)[4], u32x4 (&ucur)[4]) {
    const int g = lane >> 5, m = lane & 31, bf = n & 1;
    u32x4 un[4];
    { const bf16_t* up = UCl + (size_t)(n + 1 < 128 ? n + 1 : 127) * 8192;
#pragma unroll
      for (int i = 0; i < 4; ++i) un[i] = *(const u32x4*)(up + 8 * i); }
    const float egl = ((const LAS float*)(lds + SC_O + 2 * SC_OSZ))[n];
    const LAS unsigned char* Bf = lds + bf * SC_BUF;
    const LAS unsigned char* pW = Bf + SC_W + m * 264 + g * 8;
    const LAS unsigned char* pA = Bf + SC_A + m * 136 + g * 8;
    bf16x8 Sb[8];
#pragma unroll
    for (int s = 0; s < 8; ++s) Sb[s] = pack_h(S[s >> 1], s & 1);
    f32x16 vt[2], o[2];
    bf16x8 fA[4], fB[4];
#define SCHED_FENCE() __builtin_amdgcn_sched_barrier(0)
#define LDF(dst, p, rowstep, mt, s0) do { _Pragma("unroll") for (int i_ = 0; i_ < 4; ++i_) dst[i_] = lds_frag32((p) + (mt) * 32 * (rowstep) + ((s0) + i_) * 32); } while (0)
#define MMZ(acc, src, s0, first) do { _Pragma("unroll") for (int i_ = 0; i_ < 4; ++i_) acc = __builtin_amdgcn_mfma_f32_32x32x16_bf16(src[i_], Sb[(s0) + i_], acc, 0, 0, 0); } while (0)
#define MMV(acc, src) do { _Pragma("unroll") for (int i_ = 0; i_ < 4; ++i_) acc = __builtin_amdgcn_mfma_f32_32x32x16_bf16(src[i_], Vb[i_], acc, 0, 0, 0); } while (0)
#pragma unroll
    for (int r = 0; r < 16; ++r) { vt[0][r] = 0.f; vt[1][r] = 0.f; o[0][r] = 0.f; o[1][r] = 0.f; }
    LDF(fA, pW, 264, 0, 0); SCHED_FENCE();
    LDF(fB, pW, 264, 0, 4); MMZ(vt[0], fA, 0, 1); SCHED_FENCE();
    LDF(fA, pW, 264, 1, 0); MMZ(vt[0], fB, 4, 0); SCHED_FENCE();
    LDF(fB, pW, 264, 1, 4); MMZ(vt[1], fA, 0, 1); SCHED_FENCE();
    LDF(fA, pW + SC_Q, 264, 0, 0); MMZ(vt[1], fB, 4, 0); SCHED_FENCE();
    LDF(fB, pW + SC_Q, 264, 0, 4); MMZ(o[0], fA, 0, 1); SCHED_FENCE();
    LDF(fA, pW + SC_Q, 264, 1, 0); MMZ(o[0], fB, 4, 0); SCHED_FENCE();
    LDF(fB, pW + SC_Q, 264, 1, 4); MMZ(o[1], fA, 0, 1); SCHED_FENCE();
    LDF(fA, pA, 136, 0, 0); MMZ(o[1], fB, 4, 0);
#pragma unroll
    for (int mt = 0; mt < 2; ++mt)
#pragma unroll
        for (int q = 0; q < 8; ++q) { const unsigned uu = ucur[2 * mt + (q >> 2)][q & 3]; vt[mt][2 * q] = lo_bf(uu) - vt[mt][2 * q]; vt[mt][2 * q + 1] = hi_bf(uu) - vt[mt][2 * q + 1]; }
    bf16x8 Vb[4];
#pragma unroll
    for (int s = 0; s < 4; ++s) Vb[s] = pack_h(vt[s >> 1], s & 1);
    SCHED_FENCE();
    LDF(fB, pA, 136, 1, 0); MMV(o[0], fA); SCHED_FENCE();
    LDF(fA, pA + (SC_K - SC_A), 136, 0, 0); MMV(o[1], fB); SCHED_FENCE();
#pragma unroll
    for (int mt = 0; mt < 4; ++mt)
#pragma unroll
        for (int r = 0; r < 16; ++r) S[mt][r] *= egl;
    LDF(fB, pA + (SC_K - SC_A), 136, 1, 0); MMV(S[0], fA); SCHED_FENCE();
    LDF(fA, pA + (SC_K - SC_A), 136, 2, 0); MMV(S[1], fB); SCHED_FENCE();
    LDF(fB, pA + (SC_K - SC_A), 136, 3, 0); MMV(S[2], fA); SCHED_FENCE();
    MMV(S[3], fB); SCHED_FENCE();
#undef LDF
#undef MMZ
#undef MMV
    {
        LAS unsigned char* ob = lds + SC_O + bf * SC_OSZ + (4 * g) * 272 + (32 * cw + m) * 2;
#pragma unroll
        for (int mt = 0; mt < 2; ++mt)
#pragma unroll
            for (int r = 0; r < 16; ++r) *(LAS bf16_t*)(ob + (32 * mt + 8 * (r >> 2) + (r & 3)) * 272) = (bf16_t)(pk2(o[mt][r], 0.f) & 0xffffu);
    }
    SC_RAW_BARRIER();
#pragma unroll
    for (int i = 0; i < 4; ++i) ucur[i] = un[i];
}
DI void scan_item(LAS unsigned char* lds, const Ctx& c, int l, int bh) {
    int tid = threadIdx.x; asm volatile("" : "+v"(tid));
    const int lane = tid & 63, w = __builtin_amdgcn_readfirstlane(tid >> 6);
    const int b = bh >> 2, h = bh & 3;
    unsigned char* ws = c.ws;
    const float* GL = (const float*)(ws + WS_GL) + bh * 128;
    LAS float* glL = (LAS float*)(lds + SC_O + 2 * SC_OSZ);
    if (tid < 128) { glL[tid] = GL[tid]; glL[128 + tid] = c.gdn_g[l * 128 + tid]; }
    if (w >= 4) {
        ScanH k; k.lds = lds; k.b = b; k.h = h; k.ht = tid - 256; k.pt = k.ht >> 2; k.pseg = k.ht & 3;
        k.WC = (const bf16_t*)(ws + WS_WC) + (size_t)bh * 128 * 8192; k.QD = (const bf16_t*)(ws + WS_QD) + (size_t)bh * 128 * 8192;
        k.KD = (const bf16_t*)(ws + WS_KDT) + (size_t)bh * 128 * 8192; k.AT = (const bf16_t*)(ws + WS_AT) + (size_t)bh * 128 * 4096;
        k.Zg = (const bf16_t*)(ws + WS_Z); k.MIX = (bf16_t*)(ws + WS_MIXIN);
        u32x4 stA[14], stB[14];
        sh_load(k, 0, stA); sh_store(k, 0, stA);
        sh_load(k, 1, stB);
        BLOCK_SYNC();
        for (int n = 0; n < 128; n += 2) {
            scan_helper_step(k, n, stA, stB);
            scan_helper_step(k, n + 1, stB, stA);
        }
    } else {
        const bf16_t* UCl = (const bf16_t*)(ws + WS_UC) + (size_t)bh * 128 * 8192 + (size_t)(w * 64 + lane) * 32;
        f32x16 S[4];
#pragma unroll
        for (int i = 0; i < 4; ++i)
#pragma unroll
            for (int r = 0; r < 16; ++r) S[i][r] = 0.f;
        u32x4 ucur[4];
#pragma unroll
        for (int i = 0; i < 4; ++i) ucur[i] = *(const u32x4*)(UCl + 8 * i);
        BLOCK_SYNC();
        for (int n = 0; n < 128; ++n) scan_compute_step(lds, n, w, lane, UCl, S, ucur);
    }
    BLOCK_SYNC();
}

constexpr int AT_K = 0, AT_KSZ = 64 * 400, AT_V = 2 * AT_KSZ, AT_VSZ = 128 * 136;
DI void attn_item(LAS unsigned char* lds, const Ctx& c, int bh, int qb) {
    int tid = threadIdx.x; asm volatile("" : "+v"(tid)); const int lane = tid & 63, w = __builtin_amdgcn_readfirstlane(tid >> 6), g = lane >> 5, q = lane & 31;
    const int b = bh >> 2, h = bh & 3;
    unsigned char* ws = c.ws;
    const bf16_t* QM = (const bf16_t*)(ws + WS_QM) + (size_t)bh * SEQ * 192; const bf16_t* KN = (const bf16_t*)(ws + WS_KN) + (size_t)bh * SEQ * 128;
    const bf16_t* KR = (const bf16_t*)(ws + WS_KR) + (size_t)b * SEQ * 64; const bf16_t* VT = (const bf16_t*)(ws + WS_VT) + (size_t)bh * 128 * SEQ;
    bf16_t* MIX = (bf16_t*)(ws + WS_MIXIN);
    const int srow = qb * 256 + 32 * w + q;
    bf16x8 qf[12];
#pragma unroll
    for (int t = 0; t < 12; ++t) qf[t] = *(const bf16x8*)(QM + (size_t)srow * 192 + 16 * t + 8 * g);
    f32x16 oacc[4];
#pragma unroll
    for (int i = 0; i < 4; ++i)
#pragma unroll
        for (int r = 0; r < 16; ++r) oacc[i][r] = 0.f;
    float m_run = -1e30f, l_run = 0.f;
    const int ntile = 4 * qb + 4, my_last = 4 * qb + (w >> 1);
    u32x4 sk[3], sv[2];
    int kr_[3], kc_[3];
#pragma unroll
    for (int i = 0; i < 3; ++i) { const int id = tid + 512 * i; kr_[i] = id / 24; kc_[i] = id % 24; }
    const int vr0 = tid >> 3, vc = tid & 7;
#define AT_LOAD(kt) do { const int k0_ = (kt) * 64; \
        _Pragma("unroll") for (int i = 0; i < 3; ++i) sk[i] = kc_[i] < 16 ? *(const u32x4*)(KN + (size_t)(k0_ + kr_[i]) * 128 + kc_[i] * 8) : *(const u32x4*)(KR + (size_t)(k0_ + kr_[i]) * 64 + (kc_[i] - 16) * 8); \
        sv[0] = *(const u32x4*)(VT + (size_t)vr0 * SEQ + k0_ + vc * 8); sv[1] = *(const u32x4*)(VT + (size_t)(vr0 + 64) * SEQ + k0_ + vc * 8); } while (0)
#define AT_STORE(bf) do { LAS unsigned char* K_ = lds + AT_K + (bf) * AT_KSZ; LAS unsigned char* V_ = lds + AT_V + (bf) * AT_VSZ; \
        _Pragma("unroll") for (int i = 0; i < 3; ++i) *(LAS u32x4*)(K_ + kr_[i] * 400 + kc_[i] * 16) = sk[i]; \
        *(LAS u32x2*)(V_ + vr0 * 136 + vc * 16) = (u32x2){sv[0].x, sv[0].y}; *(LAS u32x2*)(V_ + vr0 * 136 + vc * 16 + 8) = (u32x2){sv[0].z, sv[0].w}; \
        *(LAS u32x2*)(V_ + (vr0 + 64) * 136 + vc * 16) = (u32x2){sv[1].x, sv[1].y}; *(LAS u32x2*)(V_ + (vr0 + 64) * 136 + vc * 16 + 8) = (u32x2){sv[1].z, sv[1].w}; } while (0)
    AT_LOAD(0); AT_STORE(0);
    BLOCK_SYNC();
    for (int kt = 0; kt < ntile; ++kt) {
        const int bf = kt & 1;
        if (kt + 1 < ntile) AT_LOAD(kt + 1);
        if (kt <= my_last) {
            const LAS unsigned char* Kb = lds + AT_K + bf * AT_KSZ; const LAS unsigned char* Vb = lds + AT_V + bf * AT_VSZ;
            f32x16 s0, s1;
#pragma unroll
            for (int r = 0; r < 16; ++r) { s0[r] = 0.f; s1[r] = 0.f; }
#pragma unroll
            for (int t = 0; t < 12; ++t) {
                const bf16x8 k0 = *(const LAS bf16x8*)(Kb + q * 400 + (16 * t + 8 * g) * 2);
                const bf16x8 k1 = *(const LAS bf16x8*)(Kb + (32 + q) * 400 + (16 * t + 8 * g) * 2);
                s0 = __builtin_amdgcn_mfma_f32_32x32x16_bf16(k0, qf[t], s0, 0, 0, 0);
                s1 = __builtin_amdgcn_mfma_f32_32x32x16_bf16(k1, qf[t], s1, 0, 0, 0);
            }
            float mx = s0[0];
#pragma unroll
            for (int r = 1; r < 16; ++r) mx = fmaxf(mx, s0[r]);
#pragma unroll
            for (int r = 0; r < 16; ++r) mx = fmaxf(mx, s1[r]);
            mx = fmaxf(mx, __shfl_xor(mx, 32));
            const float m_new = fmaxf(m_run, mx), alpha = __builtin_amdgcn_exp2f(m_run - m_new);
            float ps = 0.f;
#pragma unroll
            for (int r = 0; r < 16; ++r) { s0[r] = __builtin_amdgcn_exp2f(s0[r] - m_new); s1[r] = __builtin_amdgcn_exp2f(s1[r] - m_new); ps += s0[r] + s1[r]; }
            l_run = l_run * alpha + ps; m_run = m_new;
#pragma unroll
            for (int i = 0; i < 4; ++i)
#pragma unroll
                for (int r = 0; r < 16; ++r) oacc[i][r] *= alpha;
#pragma unroll
            for (int t = 0; t < 4; ++t) { const f32x16& sx = (t < 2) ? s0 : s1; const int o8 = 8 * (t & 1); u32x4 pw;
                pw.x = pk2(sx[o8 + 0], sx[o8 + 1]); pw.y = pk2(sx[o8 + 2], sx[o8 + 3]); pw.z = pk2(sx[o8 + 4], sx[o8 + 5]); pw.w = pk2(sx[o8 + 6], sx[o8 + 7]); const bf16x8 pb = __builtin_bit_cast(bf16x8, pw);
#pragma unroll
                for (int md = 0; md < 4; ++md) {
                    const LAS unsigned char* vp = Vb + (32 * md + q) * 136 + (16 * t + 4 * g) * 2;
                    const s16x4 a = *(const LAS s16x4*)vp, bb = *(const LAS s16x4*)(vp + 16);
                    oacc[md] = __builtin_amdgcn_mfma_f32_32x32x16_bf16(__builtin_shufflevector(a, bb, 0, 1, 2, 3, 4, 5, 6, 7), pb, oacc[md], 0, 0, 0);
                } }
        }
        if (kt + 1 < ntile) AT_STORE(bf ^ 1);
        BLOCK_SYNC();
    }
    l_run += __shfl_xor(l_run, 32);
    const float inv = 1.f / l_run;
    bf16_t* op = MIX + (size_t)(b * SEQ + srow) * DM + 512 + h * 128;
#pragma unroll
    for (int md = 0; md < 4; ++md)
#pragma unroll
        for (int j = 0; j < 4; ++j) { u32x2 v; v.x = pk2(oacc[md][4 * j] * inv, oacc[md][4 * j + 1] * inv); v.y = pk2(oacc[md][4 * j + 2] * inv, oacc[md][4 * j + 3] * inv);
            *(u32x2*)(op + 32 * md + 8 * j + 4 * g) = v; }
#undef AT_LOAD
#undef AT_STORE
}

DI void phase_p3(LAS unsigned char* lds, const Ctx& c, int l, int cslot) {
    (void)cslot;
    unsigned* ctr = (unsigned*)(c.ws + WS_CTR) + l * 8;
    const unsigned xid = (unsigned)__builtin_amdgcn_s_getreg((3 << 11) | 20) & 7u;
    volatile LAS int* slot = (volatile LAS int*)(lds + LDS_CTL);
    for (;;) {
        if (threadIdx.x == 0) {
            int item = -1;
            for (unsigned d = 0; d < 8u; ++d) { const unsigned qx = (xid + d) & 7u; const unsigned i = atomicAdd(ctr + qx, 1u); if (i < 66u) { item = (int)(qx * 66u + i); break; } }
            slot[0] = item;
        }
        BLOCK_SYNC();
        const int it = slot[0];
        BLOCK_SYNC();
        if (it < 0) break;
        const int qx = it / 66, i = it % 66;
        if (i < 2) scan_item(lds, c, l, 2 * qx + i);
        else { const int idx = i - 2; attn_item(lds, c, 2 * qx + (idx & 1), 31 - (idx >> 1)); }
    }
}

#define XB_TMO      128
#define XB_XCNT(j)  (256  + 64 * (j))
#define XB_XSUB(j)  (1280 + 64 * (j))
#define XB_XGEN(j)  (2304 + 64 * (j))
#define XB_TOP      3328
#define XB_TOPGEN   3392
#define XCD_BAR_WORDS 3456
#define XB_SPIN_CAP (1u << 18)

__device__ __forceinline__ unsigned xb_ld(unsigned* p)              { return __hip_atomic_load(p, __ATOMIC_RELAXED, __HIP_MEMORY_SCOPE_AGENT); }
__device__ __forceinline__ unsigned xb_add(unsigned* p, unsigned v) { return __hip_atomic_fetch_add(p, v, __ATOMIC_RELAXED, __HIP_MEMORY_SCOPE_AGENT); }
__device__ __forceinline__ unsigned xb_xcc_id() { return (unsigned)__builtin_amdgcn_s_getreg((3 << 11) | 20) & 0xFu; }
#define XB_SPIN(cond, bar) do { unsigned _sp = 0; while (cond) { __builtin_amdgcn_s_sleep(1); \
    if ((++_sp & 255u) == 0u) { if (xb_ld(&(bar)[XB_TMO])) break; if (_sp > XB_SPIN_CAP) { atomicAdd(&(bar)[XB_TMO], 1u); break; } } } } while (0)

struct XcdBarrier {
    unsigned* bar; unsigned x;
    volatile LAS unsigned* st;
};

__device__ __forceinline__ XcdBarrier xcd_barrier_post(unsigned* bar, volatile LAS unsigned* st) {
    XcdBarrier b; b.bar = bar; b.x = xb_xcc_id(); b.st = st;
    if (threadIdx.x == 0) (void)xb_add(&bar[XB_XCNT(b.x)], 1u);
    return b;
}
__device__ __forceinline__ void xcd_barrier_complete(unsigned* bar, unsigned x, unsigned& nloc, unsigned& nx) {
    const unsigned G = gridDim.x * gridDim.y * gridDim.z;
    unsigned sum, cnt, mine, sp = 0u;
    for (;;) {
        sum = 0u; cnt = 0u; mine = 0u;
#pragma unroll
        for (unsigned j = 0; j < 16; ++j) { const unsigned c = xb_ld(&bar[XB_XCNT(j)]); sum += c; cnt += (c > 0u) ? 1u : 0u; mine = (j == x) ? c : mine; }
        if (sum == G) break;
        __builtin_amdgcn_s_sleep(1);
        if ((++sp & 255u) == 0u) { if (xb_ld(&bar[XB_TMO])) break; if (sp > XB_SPIN_CAP) { atomicAdd(&bar[XB_TMO], 1u); break; } }
    }
    nloc = mine > 0u ? mine : 1u; nx = cnt > 0u ? cnt : 1u;
}

__device__ __forceinline__ void xcd_barrier(const XcdBarrier& b) {
    asm volatile("s_waitcnt vmcnt(0)" ::: "memory");
    __syncthreads();
    if (threadIdx.x == 0) {
        unsigned* bar = b.bar;
        __builtin_amdgcn_s_waitcnt(0);
        unsigned nloc = b.st[0], nx = b.st[1];
        if (nloc == 0u) { xcd_barrier_complete(bar, b.x, nloc, nx); b.st[0] = nloc; b.st[1] = nx; }
        const unsigned old = xb_add(&bar[XB_XSUB(b.x)], 1u);
        const unsigned gen = old / nloc;
        if (old + 1u == (gen + 1u) * nloc) {
            __builtin_amdgcn_fence(__ATOMIC_RELEASE, "agent");
            asm volatile("s_waitcnt vmcnt(0)" ::: "memory");
            const unsigned og = xb_add(&bar[XB_TOP], 1u);
            const unsigned tg = og / nx;
            if (og + 1u == (tg + 1u) * nx) xb_add(&bar[XB_TOPGEN], 1u);
            else XB_SPIN(xb_ld(&bar[XB_TOPGEN]) == tg, bar);
            __builtin_amdgcn_fence(__ATOMIC_ACQUIRE, "agent");
            xb_add(&bar[XB_XGEN(b.x)], 1u);
            asm volatile("s_waitcnt vmcnt(0)" ::: "memory");
        } else {
            XB_SPIN(xb_ld(&bar[XB_XGEN(b.x)]) == gen, bar);
            __builtin_amdgcn_fence(__ATOMIC_ACQUIRE, "agent");
            asm volatile("s_waitcnt vmcnt(0)" ::: "memory");
        }
    }
    __syncthreads();
}

template <int KP> __global__ void __launch_bounds__(NT, 2) fwd_kernel(Args args) {
    extern __shared__ __attribute__((aligned(16))) unsigned char lds_raw[];
    LAS unsigned char* lds = (LAS unsigned char*)lds_raw;
    cg::grid_group grid = cg::this_grid();
    if (threadIdx.x < 8) ((volatile LAS unsigned*)(lds + LDS_CTL))[threadIdx.x] = 0u;
    __syncthreads();
    typedef const __attribute__((address_space(4))) Args* ArgsP;
    const ArgsP ap0 = (ArgsP)__builtin_amdgcn_kernarg_segment_ptr();
    const int ph_lo = ap0->ph_lo, ph_hi = ap0->ph_hi;
    XcdBarrier xbar = xcd_barrier_post((unsigned*)(ap0->ws + WS_BAR), (volatile LAS unsigned*)(lds + LDS_CTL + 16));
    for (int ph = ph_lo; ph < ph_hi; ++ph) {
        const int l = ph / PH_PER_LAYER, k = ph % PH_PER_LAYER;
        ArgsP ap = ap0; asm volatile("" : "+s"(ap));
        Ctx c;
        c.x = (const float*)ap->in[0]; c.p = (const float*)ap->in[1]; c.pos = (const int*)ap->in[2]; c.w_in = (const float*)ap->in[3]; c.conv_w = (const float*)ap->in[4];
        c.a_log = (const float*)ap->in[5]; c.dt_bias = (const float*)ap->in[6]; c.gdn_g = (const float*)ap->in[7]; c.qn_g = (const float*)ap->in[8]; c.w_uq = (const float*)ap->in[9];
        c.kvn_g = (const float*)ap->in[10]; c.w_ukv = (const float*)ap->in[11]; c.w_out = (const float*)ap->in[12]; c.ln1_g = (const float*)ap->in[13]; c.ln1_b = (const float*)ap->in[14];
        c.w_gu = (const float*)ap->in[15]; c.w_dn = (const float*)ap->in[16]; c.ln2_g = (const float*)ap->in[17]; c.ln2_b = (const float*)ap->in[18]; c.w_ple = (const float*)ap->in[19]; c.w_pg = (const float*)ap->in[20];
        c.out = ap->out; c.ws = ap->ws;
        unsigned char* ws = c.ws;
        const float* xres = l == 0 ? c.x : c.out;
        if constexpr (KP >= 0) { if (k != KP) continue; }
        switch (k) {
        case 0: phase_p0(lds, c, l);
#ifdef DUP_P0
                phase_p0(lds, c, l);
#endif
                break;
        case 1: asm volatile("; MARK_CASE_1"); { EpiIn E{ws};
                  run_gemm(lds, (const bf16_t*)(ws + WS_XB), (const bf16_t*)(ws + W_IN), T, NIN, 1024, E); } break;
        case 2: { EpiQ EQ{ws}; run_gemm(lds, (const bf16_t*)(ws + WS_CQ), (const bf16_t*)(ws + W_UQ), T, 768, 384, EQ);
#ifdef DUP_P2G
                  run_gemm(lds, (const bf16_t*)(ws + WS_CQ), (const bf16_t*)(ws + W_UQ), T, 768, 384, EQ);
#endif
                  } break;
        case 3: { EpiKV EK{ws}; run_gemm(lds, (const bf16_t*)(ws + WS_CKV), (const bf16_t*)(ws + W_UKV), T, 1024, 256, EK);
#ifdef DUP_P2G
                  run_gemm(lds, (const bf16_t*)(ws + WS_CKV), (const bf16_t*)(ws + W_UKV), T, 1024, 256, EK);
#endif
                  } break;
        case 4: for (int it = blockIdx.x; it < 2048; it += gridDim.x) gdn_prep_item(lds, c, l, it);
#ifdef DUP_PREP
                for (int it = blockIdx.x; it < 2048; it += gridDim.x) gdn_prep_item(lds, c, l, it);
#endif
                break;
        case 5: phase_p3(lds, c, l, l); break;
        case 6: { EpiOut E{xres, ws, c.ln1_g + l * DM}; run_gemm(lds, (const bf16_t*)(ws + WS_MIXIN), (const bf16_t*)(ws + W_OUT), T, 1024, 1024, E); } break;
        case 7: { EpiSwiGLU E{ws, (const float*)(ws + WS_GW) + (size_t)l * GW_LAYER}; run_gemm(lds, (const bf16_t*)(ws + WS_X1B), (const bf16_t*)(ws + W_GU), T, 2 * DFF, 1024, E); } break;
        case 8: { EpiDown E{ws, c.ln1_g + l * DM, c.ln1_b + l * DM, c.ln2_g + l * DM}; run_gemm(lds, (const bf16_t*)(ws + WS_HID), (const bf16_t*)(ws + W_DN), T, 1024, DFF, E); } break;
        case 9: { EpiE E1{ws}; run_gemm(lds, (const bf16_t*)(ws + WS_PB), (const bf16_t*)(ws + W_PLE), T, 1024, 256, E1); } break;
        default: { EpiPle E2{ws, c.ln2_g + l * DM, c.ln2_b + l * DM, c.out, (const float*)(ws + WS_GW) + (size_t)l * GW_LAYER + 2 * 5632}; run_gemm(lds, (const bf16_t*)(ws + WS_X1B), (const bf16_t*)(ws + W_PG), T, 1024, 1024, E2); } break;
        }
        if (ph + 1 < ph_hi && k != 2 && k != 3 && k != 9) { if (ph == 0) grid.sync(); else xcd_barrier(xbar); }
    }
}


#ifndef MEGA
#define MEGA 1
#endif
typedef void (*KernT)(Args);
#if !MEGA
static KernT phase_kernel(int k) {
    switch (k) { case 0: return fwd_kernel<0>; case 1: return fwd_kernel<1>; case 2: return fwd_kernel<2>; case 3: return fwd_kernel<3>; case 4: return fwd_kernel<4>; case 5: return fwd_kernel<5>;
                 case 6: return fwd_kernel<6>; case 7: return fwd_kernel<7>; case 8: return fwd_kernel<8>; case 9: return fwd_kernel<9>; default: return fwd_kernel<10>; }
}
#endif
extern "C" void kernel_launch(void* const* d_in, const int* in_sizes, int n_in, void* d_out, int out_size, void* d_ws, size_t ws_size, hipStream_t stream) {
    static int grid = 0;
    if (grid == 0) {
        if (n_in != 21 || out_size != T * DM || ws_size < WS_END) { fprintf(stderr, "kernel_launch: unexpected problem (n_in %d out %d ws %zu, need %zu)\n", n_in, out_size, ws_size, (size_t)WS_END); grid = -1; return; }
        int dev = 0, cus = 0;
        (void)hipGetDevice(&dev); (void)hipDeviceGetAttribute(&cus, hipDeviceAttributeMultiprocessorCount, dev);
        bool ok = true;
#if MEGA
        ok = hipFuncSetAttribute((const void*)fwd_kernel<-1>, hipFuncAttributeMaxDynamicSharedMemorySize, LDS_BYTES) == hipSuccess;
#else
        for (int k = 0; k < PH_PER_LAYER; ++k) ok = ok && hipFuncSetAttribute((const void*)phase_kernel(k), hipFuncAttributeMaxDynamicSharedMemorySize, LDS_BYTES) == hipSuccess;
#endif
        if (!ok) { fprintf(stderr, "kernel_launch: hipFuncSetAttribute failed\n"); grid = -1; return; }
        (void)hipGetLastError();
        grid = cus;
    }
    if (grid < 0) return;
    Args a{};
    for (int i = 0; i < 21; ++i) a.in[i] = d_in[i];
    a.out = (float*)d_out; a.ws = (unsigned char*)d_ws;
    if (hipMemsetAsync((unsigned char*)d_ws + WS_GW, 0, (size_t)DEPTH * GW_LAYER * 4 + XCD_BAR_WORDS * 4, stream) != hipSuccess) { fprintf(stderr, "kernel_launch: memset of the barrier words failed\n"); return; }
#if MEGA
    a.ph_lo = 0; a.ph_hi = NPHASE;
    { void* kargs[] = {&a};
      hipError_t e = hipLaunchCooperativeKernel((const void*)fwd_kernel<-1>, dim3(grid), dim3(NT), kargs, LDS_BYTES, stream);
      if (e != hipSuccess) fprintf(stderr, "cooperative launch failed: %s (grid %d)\n", hipGetErrorString(e), grid); }
#else
    for (int ph = 0; ph < NPHASE; ++ph) {
        a.ph_lo = ph; a.ph_hi = ph + 1;
        void* kargs[] = {&a};
        hipError_t e = hipLaunchCooperativeKernel((const void*)phase_kernel(ph % PH_PER_LAYER), dim3(grid), dim3(NT), kargs, LDS_BYTES, stream);
        if (e != hipSuccess) { fprintf(stderr, "cooperative launch failed: %s (grid %d)\n", hipGetErrorString(e), grid); break; }
    }
#endif
}
```
